# Optimizing an MI355X kernel written in HIP

```python
import math
import jax
import jax.numpy as jnp
from jax import lax
import numpy as np

D_MODEL = 2048
BATCH = 4
SEQ = 4096
DEPTH = 2

GRID_W = 64
CTX_LEN = 256
N_MOD = 9
D_FF = 5632
RET_WIDTH = D_MODEL // 2
RET_HEADS = 8
RET_HEAD_DIM = RET_WIDTH // RET_HEADS
HY_WIDTH = D_MODEL - RET_WIDTH
HY_ORDER = 2
HY_SHORT = 3
HY_EMB_DIM = 33
HY_HIDDEN = 64
HY_DECAY_SHORT_PCT = 0.3
HY_DECAY_LONG_PCT = 1.5
HY_DECAY_TARGET = 1e-2
CHUNK = 128
ROPE_BASE = 10000.0
POOL_WINDOWS = (2, 4, 8, 16)
POOL_GROUP = D_MODEL // len(POOL_WINDOWS)
PROJ_WIDTH = 4 * RET_WIDTH + (HY_ORDER + 1) * HY_WIDTH
EPS = 1e-6
F32 = jnp.float32

kernel_name = "hybrid_retnet_hyena_pool_macaron"


def rms_norm(x):
    xf = x.astype(F32)
    return (xf * lax.rsqrt(jnp.mean(xf * xf, axis=-1, keepdims=True) + EPS)).astype(x.dtype)


def modulate(x, mod, base):
    return rms_norm(x) * (1.0 + mod[:, base + 1]) + mod[:, base]


def swiglu(h, w1, w3, w2):
    return (jax.nn.silu(h @ w1) * (h @ w3)) @ w2


def ffn_half(x, mod, base, w1, w3, w2):
    h = modulate(x, mod, base)
    return x + 0.5 * mod[:, base + 2] * swiglu(h, w1, w3, w2)


def axial_rotary(n, dtype):
    pos = jnp.arange(n)
    row = (pos // GRID_W).astype(F32)
    col = (pos % GRID_W).astype(F32)
    n_freq = RET_HEAD_DIM // 4
    inv = ROPE_BASE ** (-jnp.arange(n_freq, dtype=F32) / n_freq)
    ang = jnp.concatenate([row[:, None] * inv, col[:, None] * inv], axis=-1)
    return jnp.cos(ang).astype(dtype), jnp.sin(ang).astype(dtype)


def apply_rotary(x, cos, sin):
    half = x.shape[-1] // 2
    x1, x2 = x[..., :half], x[..., half:]
    c, s = cos[:, None, :], sin[:, None, :]
    return jnp.concatenate([x1 * c - x2 * s, x2 * c + x1 * s], axis=-1)


def retention_chunkwise(q, k, v, log_gamma, s0):
    b, n, h, d = q.shape
    nc = n // CHUNK
    dt = q.dtype
    lg = log_gamma.astype(F32)
    pos = jnp.arange(CHUNK, dtype=F32)
    diff = pos[:, None] - pos[None, :]
    decay_in = jnp.where(diff >= 0, jnp.exp(jnp.maximum(diff, 0.0)[None] * lg[:, None, None]), 0.0).astype(dt)
    q_dec = jnp.exp((pos + 1.0)[None, :] * lg[:, None]).astype(dt)
    k_dec = jnp.exp((CHUNK - 1.0 - pos)[None, :] * lg[:, None]).astype(dt)
    chunk_dec = jnp.exp(CHUNK * lg).astype(dt)
    qc = q.reshape(b, nc, CHUNK, h, d)
    kc = k.reshape(b, nc, CHUNK, h, d)
    vc = v.reshape(b, nc, CHUNK, h, d)
    scores = jnp.einsum('bnihd,bnjhd->bnhij', qc, kc) * decay_in
    inner = jnp.einsum('bnhij,bnjhe->bnihe', scores, vc)
    upd = jnp.einsum('bnjhd,hj,bnjhe->nbhde', kc, k_dec, vc)

    def step(s, u):
        return chunk_dec[None, :, None, None] * s + u, s

    s_fin, s_prev = lax.scan(step, s0, upd)
    cross = jnp.einsum('bnihd,hi,nbhde->bnihe', qc, q_dec, s_prev)
    return (inner + cross).reshape(b, n, h, d), s_fin


def bi_retention(q, k, v, log_gamma, s0_f, s0_b):
    out_f, s_f = retention_chunkwise(q, k, v, log_gamma[0], s0_f)
    out_b, s_b = retention_chunkwise(q[:, ::-1], k[:, ::-1], v[:, ::-1], log_gamma[1], s0_b)
    return out_f + out_b[:, ::-1], s_f, s_b


def retention_final_states(k, v, log_gamma):
    n = k.shape[1]
    pos = jnp.arange(n, dtype=F32)
    lg = log_gamma.astype(F32)
    w_f = jnp.exp((n - 1.0 - pos)[None, :] * lg[0][:, None]).astype(k.dtype)
    w_b = jnp.exp(pos[None, :] * lg[1][:, None]).astype(k.dtype)
    s_f = jnp.einsum('blhd,hl,blhe->bhde', k, w_f, v)
    s_b = jnp.einsum('blhd,hl,blhe->bhde', k, w_b, v)
    return s_f, s_b


def short_conv(u, w, bias):
    n = u.shape[1]
    pad = HY_SHORT // 2
    up = jnp.pad(u, ((0, 0), (pad, HY_SHORT - 1 - pad), (0, 0)))
    out = bias + up[:, 0:n] * w[0]
    for j in range(1, HY_SHORT):
        out = out + up[:, j:j + n] * w[j]
    return out


def hyena_filters(n, fw1, fb1, fw2, fb2, fw3, fb3, freq, fw4):
    t = jnp.linspace(0.0, 1.0, n, dtype=F32)[:, None]
    bands = (HY_EMB_DIM - 1) // 2
    f = jnp.linspace(1e-4, bands - 1, bands, dtype=F32)[None, :]
    w = 2.0 * math.pi * jnp.arange(n, dtype=F32)[:, None] / n
    z = jnp.concatenate([t, jnp.cos(f * w), -jnp.sin(f * w)], axis=-1).astype(fw1.dtype)
    a = jnp.sin(freq[0] * (z @ fw1 + fb1))
    a = jnp.sin(freq[1] * (a @ fw2 + fb2))
    a = jnp.sin(freq[2] * (a @ fw3 + fb3))
    hf = (a @ fw4).astype(F32).reshape(n, HY_ORDER, 2, HY_WIDTH)
    max_decay = math.log(HY_DECAY_TARGET) / HY_DECAY_SHORT_PCT
    min_decay = math.log(HY_DECAY_TARGET) / HY_DECAY_LONG_PCT
    deltas = jnp.abs(jnp.linspace(min_decay, max_decay, HY_WIDTH, dtype=F32))
    window = jnp.exp(-t * deltas[None, :])
    return hf * window[:, None, None, :]


def long_conv_bidir(u, h_fwd, h_bwd, bias):
    n = u.shape[1]
    k_full = jnp.concatenate([h_fwd, jnp.zeros_like(h_fwd[:1]), h_bwd[:0:-1]], axis=0)
    uf = jnp.fft.rfft(u.astype(F32), n=2 * n, axis=1)
    kf = jnp.fft.rfft(k_full, n=2 * n, axis=0)
    y = jnp.fft.irfft(uf * kf[None], n=2 * n, axis=1)[:, :n]
    return (y + u.astype(F32) * bias.astype(F32)).astype(u.dtype)


def hyena(p, conv_w, conv_b, filt, bias):
    u = short_conv(p, conv_w, conv_b)
    v, x1, x2 = jnp.split(u, HY_ORDER + 1, axis=-1)
    z = x1 * long_conv_bidir(v, filt[:, 0, 0], filt[:, 0, 1], bias[0])
    return x2 * long_conv_bidir(z, filt[:, 1, 0], filt[:, 1, 1], bias[1])


def ab_mixer(h, w_in, w_out, log_decay, conv_w, conv_b, filt, hy_bias, rot, s0_f, s0_b):
    b, n, _ = h.shape
    p = h @ w_in
    q, k, v, g = jnp.split(p[..., :4 * RET_WIDTH], 4, axis=-1)
    heads = (b, n, RET_HEADS, RET_HEAD_DIM)
    q = q.reshape(heads)
    k = k.reshape(heads) * RET_HEAD_DIM ** -0.5
    v = v.reshape(heads)
    if rot is not None:
        q = apply_rotary(q, rot[0], rot[1])
        k = apply_rotary(k, rot[0], rot[1])
    r, s_f, s_b = bi_retention(q, k, v, log_decay, s0_f, s0_b)
    r = rms_norm(r).reshape(b, n, RET_WIDTH) * jax.nn.silu(g)
    y_h = hyena(p[..., 4 * RET_WIDTH:], conv_w, conv_b, filt, hy_bias)
    y = jnp.concatenate([r, y_h], axis=-1) @ w_out
    return y, s_f, s_b


def box_mean(x, axis, win):
    n = x.shape[axis]
    lo, hi = -(win // 2), win - 1 - win // 2
    xf = x.astype(F32)
    zero = jnp.zeros_like(lax.slice_in_dim(xf, 0, 1, axis=axis))
    cs = jnp.concatenate([zero, jnp.cumsum(xf, axis=axis)], axis=axis)
    idx = jnp.arange(n)
    top = jnp.minimum(idx + hi, n - 1) + 1
    bot = jnp.maximum(idx + lo, 0)
    total = jnp.take(cs, top, axis=axis) - jnp.take(cs, bot, axis=axis)
    shape = [1] * x.ndim
    shape[axis] = n
    cnt = (top - bot).astype(F32).reshape(shape)
    return (total / cnt).astype(x.dtype)


def pool_mixer(h, w, scale, on_grid):
    b, n, d = h.shape
    if on_grid:
        rows = n // GRID_W
        hh = h.reshape(b, rows, GRID_W, d)
    else:
        hh = h
    outs = []
    for gi, win in enumerate(POOL_WINDOWS):
        xg = hh[..., gi * POOL_GROUP:(gi + 1) * POOL_GROUP]
        if on_grid:
            m = box_mean(box_mean(xg, 2, win), 1, win)
        else:
            m = box_mean(xg, 1, win)
        outs.append((m - xg) @ w[gi])
    return jnp.concatenate(outs, axis=-1).reshape(b, n, d) * scale


def setup_inputs(seed: int = 0) -> dict:
    key = jax.random.key(seed)
    ks = jax.random.split(key, 29)
    n_even = (DEPTH + 1) // 2
    n_odd = DEPTH // 2

    def nrm(k, shape, std):
        return jax.random.normal(k, shape, F32) * std

    base_decay = jnp.log(1.0 - 2.0 ** (-5.0 - jnp.arange(RET_HEADS, dtype=F32)))
    return {
        'x': nrm(ks[0], (BATCH, SEQ, D_MODEL), 1.0),
        'c': nrm(ks[1], (BATCH, D_MODEL), 1.0),
        'ctx': nrm(ks[2], (BATCH, CTX_LEN, D_MODEL), 1.0),
        'c_ctx': nrm(ks[3], (D_MODEL,), 1.0),
        'w_mod': nrm(ks[4], (DEPTH, D_MODEL, N_MOD * D_MODEL), 0.5 * D_MODEL ** -0.5),
        'b_mod': nrm(ks[5], (DEPTH, N_MOD * D_MODEL), 0.02),
        'ffn1_w1': nrm(ks[6], (DEPTH, D_MODEL, D_FF), D_MODEL ** -0.5),
        'ffn1_w3': nrm(ks[7], (DEPTH, D_MODEL, D_FF), D_MODEL ** -0.5),
        'ffn1_w2': nrm(ks[8], (DEPTH, D_FF, D_MODEL), D_FF ** -0.5),
        'ffn2_w1': nrm(ks[9], (DEPTH, D_MODEL, D_FF), D_MODEL ** -0.5),
        'ffn2_w3': nrm(ks[10], (DEPTH, D_MODEL, D_FF), D_MODEL ** -0.5),
        'ffn2_w2': nrm(ks[11], (DEPTH, D_FF, D_MODEL), D_FF ** -0.5),
        'ab_w_in': nrm(ks[12], (n_even, D_MODEL, PROJ_WIDTH), D_MODEL ** -0.5),
        'ab_w_out': nrm(ks[13], (n_even, D_MODEL, D_MODEL), D_MODEL ** -0.5),
        'ret_log_decay': base_decay * (1.0 + 0.05 * jax.random.normal(ks[14], (n_even, 2, RET_HEADS), F32)),
        'hy_conv_w': nrm(ks[15], (n_even, HY_SHORT, (HY_ORDER + 1) * HY_WIDTH), HY_SHORT ** -0.5),
        'hy_conv_b': nrm(ks[16], (n_even, (HY_ORDER + 1) * HY_WIDTH), 0.02),
        'hy_f_w1': nrm(ks[17], (n_even, HY_EMB_DIM, HY_HIDDEN), HY_EMB_DIM ** -0.5),
        'hy_f_b1': nrm(ks[18], (n_even, HY_HIDDEN), 0.1),
        'hy_f_w2': nrm(ks[19], (n_even, HY_HIDDEN, HY_HIDDEN), HY_HIDDEN ** -0.5),
        'hy_f_b2': nrm(ks[20], (n_even, HY_HIDDEN), 0.1),
        'hy_f_w3': nrm(ks[21], (n_even, HY_HIDDEN, HY_HIDDEN), HY_HIDDEN ** -0.5),
        'hy_f_b3': nrm(ks[22], (n_even, HY_HIDDEN), 0.1),
        'hy_f_freq': 1.0 + nrm(ks[23], (n_even, 3, HY_HIDDEN), 0.1),
        'hy_f_w4': nrm(ks[24], (n_even, HY_HIDDEN, HY_ORDER * 2 * HY_WIDTH), 0.005),
        'hy_bias': nrm(ks[25], (n_even, HY_ORDER, HY_WIDTH), 0.5),
        'pool_w': nrm(ks[26], (n_odd, len(POOL_WINDOWS), POOL_GROUP, POOL_GROUP), POOL_GROUP ** -0.5),
        'pool_scale': 1.0 + nrm(ks[27], (n_odd, D_MODEL), 0.1),
        'final_gain': 1.0 + nrm(ks[28], (D_MODEL,), 0.1),
    }


def reference(x, c, ctx, c_ctx, w_mod, b_mod, ffn1_w1, ffn1_w3, ffn1_w2, ffn2_w1, ffn2_w3, ffn2_w2,
              ab_w_in, ab_w_out, ret_log_decay, hy_conv_w, hy_conv_b, hy_f_w1, hy_f_b1, hy_f_w2, hy_f_b2,
              hy_f_w3, hy_f_b3, hy_f_freq, hy_f_w4, hy_bias, pool_w, pool_scale, final_gain):
    b, n, d = x.shape
    n_ctx = ctx.shape[1]
    rot = axial_rotary(n, x.dtype)
    sc = jax.nn.silu(c)
    sc_ctx = jax.nn.silu(c_ctx)[None, :]
    for i in range(DEPTH):
        ctx_out = any(j % 2 == 0 for j in range(i + 1, DEPTH))
        ctx_in = (i % 2 == 0) or ctx_out
        mod = (sc @ w_mod[i] + b_mod[i]).reshape(b, N_MOD, 1, d)
        x = ffn_half(x, mod, 0, ffn1_w1[i], ffn1_w3[i], ffn1_w2[i])
        h = modulate(x, mod, 3)
        if ctx_in:
            mod_c = (sc_ctx @ w_mod[i] + b_mod[i]).reshape(1, N_MOD, 1, d)
            ctx = ffn_half(ctx, mod_c, 0, ffn1_w1[i], ffn1_w3[i], ffn1_w2[i])
            h_c = modulate(ctx, mod_c, 3)
        if i % 2 == 0:
            e = i // 2
            fparams = (hy_f_w1[e], hy_f_b1[e], hy_f_w2[e], hy_f_b2[e], hy_f_w3[e], hy_f_b3[e], hy_f_freq[e], hy_f_w4[e])
            if ctx_out:
                zero = jnp.zeros((ctx.shape[0], RET_HEADS, RET_HEAD_DIM, RET_HEAD_DIM), ctx.dtype)
                y_c, s_f, s_b = ab_mixer(h_c, ab_w_in[e], ab_w_out[e], ret_log_decay[e], hy_conv_w[e], hy_conv_b[e],
                                         hyena_filters(n_ctx, *fparams), hy_bias[e], None, zero, zero)
            else:
                heads_c = (ctx.shape[0], n_ctx, RET_HEADS, RET_HEAD_DIM)
                k_c = (h_c @ ab_w_in[e][:, RET_WIDTH:2 * RET_WIDTH]).reshape(heads_c) * RET_HEAD_DIM ** -0.5
                v_c = (h_c @ ab_w_in[e][:, 2 * RET_WIDTH:3 * RET_WIDTH]).reshape(heads_c)
                s_f, s_b = retention_final_states(k_c, v_c, ret_log_decay[e])
            y, _, _ = ab_mixer(h, ab_w_in[e], ab_w_out[e], ret_log_decay[e], hy_conv_w[e], hy_conv_b[e],
                               hyena_filters(n, *fparams), hy_bias[e], rot, s_f, s_b)
        else:
            o = i // 2
            y = pool_mixer(h, pool_w[o], pool_scale[o], True)
            if ctx_out:
                y_c = pool_mixer(h_c, pool_w[o], pool_scale[o], False)
        x = x + mod[:, 5] * y
        x = ffn_half(x, mod, 6, ffn2_w1[i], ffn2_w3[i], ffn2_w2[i])
        if ctx_out:
            ctx = ctx + mod_c[:, 5] * y_c
            ctx = ffn_half(ctx, mod_c, 6, ffn2_w1[i], ffn2_w3[i], ffn2_w2[i])
    return rms_norm(x) * final_gain
```

```cpp
#include <hip/hip_runtime.h>
#include <cstdio>
#include <cstdint>

#ifndef MK_PER_PHASE_LAUNCH
#define MK_PER_PHASE_LAUNCH 0
#endif
#ifndef F8_UP
#define F8_UP 1
#endif
#ifndef F8_DN
#define F8_DN 1
#endif
#ifndef DUP_PHASE
#define DUP_PHASE -1
#endif
#ifndef HY_NAIVE
#define HY_NAIVE 0
#endif

constexpr int NWAVES = 8, NTHR = 512;
constexpr int DM = 2048, NB = 4, SEQ = 4096, CTXL = 256;
constexpr int ML = NB * SEQ, MC = NB * CTXL, MA = ML + MC;
constexpr int DFF = 5632, NUP = 2 * DFF, MODW = 9 * DM;
constexpr int NPROJ = 7168, KS_MOD = 16;
constexpr int NPHASE = 23;

constexpr size_t MiB = 1u << 20;
constexpr size_t WS_CTL = 0, CTL_ZERO_BYTES = 1 * MiB;
constexpr size_t WS_MODP = 1 * MiB;
constexpr size_t WS_MOD = 13 * MiB;
constexpr size_t WS_A3 = 14 * MiB;
constexpr size_t WS_ROTC = 15 * MiB, WS_ROTS = 16 * MiB;
constexpr size_t WS_WUP = 17 * MiB;
constexpr size_t WS_WDN = 193 * MiB;
constexpr size_t WS_WIN = 281 * MiB;
constexpr size_t WS_WOUT = 309 * MiB;
constexpr size_t WS_WPOOL = 317 * MiB;
constexpr size_t WS_X = 319 * MiB;
constexpr size_t WS_HN = 455 * MiB;
constexpr size_t WS_HID = 523 * MiB;
constexpr size_t WS_QKVG = 523 * MiB;
constexpr size_t WS_KVC = 651 * MiB;
constexpr size_t WS_YHT = 655 * MiB;
constexpr size_t WS_TC = 523 * MiB;
constexpr size_t WS_DD = 587 * MiB;
constexpr size_t WS_PHT = 710 * MiB;
constexpr size_t WS_SPREV = 806 * MiB;
constexpr size_t WS_KR = 870 * MiB;
constexpr size_t WS_END = 902 * MiB;
constexpr int CW_TMO = 0, CW_BAR = 4096;

namespace pg8 {
#define PG8_LAS __attribute__((address_space(3)))
typedef unsigned short bf16_t;
typedef short bf16x8 __attribute__((ext_vector_type(8)));
typedef float f32x4 __attribute__((ext_vector_type(4)));
typedef unsigned u32x4 __attribute__((ext_vector_type(4)));
constexpr int BM = 256, BK = 64, HALF = 128, HTB = HALF * BK * 2, STAGE_BYTES = 8 * HTB, NXCD = 8, WGM = 4;

__host__ __device__ __forceinline__ int lds_byte(int r, int c) { const int st = (r >> 4) * 2 + (c >> 5), rr = r & 15, cc = c & 31, ob = rr * 64 + cc * 2; return st * 1024 + (ob ^ (((ob >> 9) & 1) << 5)); }
__host__ __device__ __forceinline__ void stage_rc(int b, int& R, int& C) { const int st = b / 1024, sb = b % 1024, swz = sb ^ (((sb >> 9) & 1) << 5); R = (st >> 1) * 16 + swz / 64; C = (st & 1) * 32 + (swz % 64) / 2; }
__host__ __device__ __forceinline__ int perm32(int rho) { const int n = rho >> 4, i = rho & 15; return 8 * (i >> 2) + 4 * n + (i & 3); }

struct Unit { int pm, pn, ty; const char* A; const char* B; };
struct Gemm { int K, lda, ldb; };

__device__ __forceinline__ void tile_of(int L, int nM, int nN, int& pm, int& pn) {
    const int nwg = nM * nN; int wgid = L;
    { const int q = nwg / NXCD, r = nwg % NXCD, xcd = wgid % NXCD, off = wgid / NXCD; wgid = (xcd < r ? xcd * (q + 1) : r * (q + 1) + (xcd - r) * q) + off; }
    const int nig = WGM * nN, gid = wgid / nig, fm = gid * WGM, gsz = (nM - fm) < WGM ? (nM - fm) : WGM;
    pm = fm + ((wgid % nig) % gsz); pn = (wgid % nig) / gsz;
}
struct StaticOrder {
    int nM, nN, nwg, G, c; const char* A; const char* B; size_t astep, bstep;
    __device__ void init(const void* A_, const void* B_, int M, int N, int lda, int ldb, int G_, int c_) { nM = M / BM; nN = N / BM; nwg = nM * nN; G = G_; c = c_; A = (const char*)A_; B = (const char*)B_; astep = (size_t)BM * lda * 2; bstep = (size_t)BM * ldb * 2; }
    __device__ __forceinline__ bool next(int i, Unit& u) const {
        const long L = (long)i * G + c; if (L >= nwg) return false;
        tile_of((int)L, nM, nN, u.pm, u.pn); u.ty = 0; u.A = A + (size_t)u.pm * astep; u.B = B + (size_t)u.pn * bstep; return true;
    }
};

__device__ __forceinline__ unsigned cvt_pk_bf16(float lo, float hi) { unsigned r; asm volatile("v_cvt_pk_bf16_f32 %0, %1, %2" : "=v"(r) : "v"(lo), "v"(hi)); return r; }
__device__ __forceinline__ float silu_f(float a) { return a * __builtin_amdgcn_rcpf(1.0f + __builtin_amdgcn_exp2f(-1.44269504089f * a)); }


typedef int i32x8 __attribute__((ext_vector_type(8)));
typedef int i32x4 __attribute__((ext_vector_type(4)));
__device__ __forceinline__ float clamp_f8(float v) { return __builtin_fminf(__builtin_fmaxf(v, -448.0f), 448.0f); }
__device__ __forceinline__ unsigned pack4_fp8(float a, float b, float c, float d) {
    int w = __builtin_amdgcn_cvt_pk_fp8_f32(clamp_f8(a), clamp_f8(b), 0, false); w = __builtin_amdgcn_cvt_pk_fp8_f32(clamp_f8(c), clamp_f8(d), w, true); return (unsigned)w; }
constexpr float F8S_ACT = 16.0f, F8S_WUP = 256.0f, F8S_HID = 8.0f, F8S_WDN = 512.0f;

template <bool F8OUT> struct EpiSwiglu {
    static constexpr bool PERM = true;
    void* H; int ldh; float dsc;
    __device__ __forceinline__ void operator()(const f32x4 (&acc)[2][2][4][2], const Unit& u, int wr, int wc, int fr, int fq) const {
        const int row0 = u.pm * BM + wr * 64 + fr, col0 = u.pn * HALF + wc * 32 + 8 * fq;
#pragma unroll
        for (int ai = 0; ai < 2; ++ai)
#pragma unroll
            for (int m = 0; m < 4; ++m) {
                const f32x4 a0 = acc[ai][0][m][0] * dsc, a1 = acc[ai][0][m][1] * dsc, b0 = acc[ai][1][m][0] * dsc, b1 = acc[ai][1][m][1] * dsc;
                if constexpr (F8OUT) {
                    typedef unsigned u32x2_ __attribute__((ext_vector_type(2)));
                    u32x2_ w8;
                    w8.x = pack4_fp8(silu_f(a0[0]) * b0[0] * F8S_HID, silu_f(a0[1]) * b0[1] * F8S_HID, silu_f(a0[2]) * b0[2] * F8S_HID, silu_f(a0[3]) * b0[3] * F8S_HID);
                    w8.y = pack4_fp8(silu_f(a1[0]) * b1[0] * F8S_HID, silu_f(a1[1]) * b1[1] * F8S_HID, silu_f(a1[2]) * b1[2] * F8S_HID, silu_f(a1[3]) * b1[3] * F8S_HID);
                    *(u32x2_*)((unsigned char*)H + (size_t)(row0 + ai * HALF + m * 16) * ldh + col0) = w8;
                    continue;
                }
                u32x4 w;
                w.x = cvt_pk_bf16(silu_f(a0[0]) * b0[0], silu_f(a0[1]) * b0[1]); w.y = cvt_pk_bf16(silu_f(a0[2]) * b0[2], silu_f(a0[3]) * b0[3]);
                w.z = cvt_pk_bf16(silu_f(a1[0]) * b1[0], silu_f(a1[1]) * b1[1]); w.w = cvt_pk_bf16(silu_f(a1[2]) * b1[2], silu_f(a1[3]) * b1[3]);
                *(u32x4*)((bf16_t*)H + (size_t)(row0 + ai * HALF + m * 16) * ldh + col0) = w;
            }
    }
};
template <bool BF32> struct EpiResid {
    static constexpr bool PERM = true;
    const void* base_lat; const void* base_ctx; bf16_t* out; const float* gate; int gate_rstride; const float* gate2; float fac;
    __device__ __forceinline__ void operator()(const f32x4 (&acc)[2][2][4][2], const Unit& u, int wr, int wc, int fr, int fq) const {
        const int row0 = u.pm * BM + wr * 64 + fr, col0 = u.pn * BM + wc * 32 + 8 * fq;
        const int rb = u.pm < 64 ? (u.pm >> 4) : 4;
        const float* g = gate + (size_t)rb * gate_rstride;
        f32x4 gv[2][2];
#pragma unroll
        for (int bj = 0; bj < 2; ++bj)
#pragma unroll
            for (int n = 0; n < 2; ++n) { gv[bj][n] = *(const f32x4*)(g + col0 + bj * HALF + n * 4) * fac; if (gate2) gv[bj][n] = gv[bj][n] * *(const f32x4*)(gate2 + col0 + bj * HALF + n * 4); }
#define RES_OFF(R) ((size_t)(row0 + ((R) >> 2) * HALF + ((R) & 3) * 16) * 2048 + col0)
        if constexpr (BF32) {
            const float* base = u.pm < 64 ? (const float*)base_lat : ((const float*)base_ctx - (size_t)16384 * 2048);
            constexpr int AH = 3;
            f32x4 bs[8][2][2];
#define RES_LOAD(R) do { const size_t off_ = RES_OFF(R); _Pragma("unroll") for (int bj = 0; bj < 2; ++bj) _Pragma("unroll") for (int n = 0; n < 2; ++n) bs[R][bj][n] = *(const f32x4*)(base + off_ + bj * HALF + n * 4); } while (0)
#pragma unroll
            for (int R = 0; R < AH; ++R) RES_LOAD(R);
            __builtin_amdgcn_sched_barrier(0);
#pragma unroll
            for (int R = 0; R < 8; ++R) {
                if (R + AH < 8) RES_LOAD(R + AH);
                __builtin_amdgcn_sched_barrier(0);
                const size_t off = RES_OFF(R);
#pragma unroll
                for (int bj = 0; bj < 2; ++bj) { const f32x4 o0 = bs[R][bj][0] + gv[bj][0] * acc[R >> 2][bj][R & 3][0], o1 = bs[R][bj][1] + gv[bj][1] * acc[R >> 2][bj][R & 3][1];
                    u32x4 w; w.x = cvt_pk_bf16(o0[0], o0[1]); w.y = cvt_pk_bf16(o0[2], o0[3]); w.z = cvt_pk_bf16(o1[0], o1[1]); w.w = cvt_pk_bf16(o1[2], o1[3]);
                    *(u32x4*)(out + off + bj * HALF) = w; }
                __builtin_amdgcn_sched_barrier(0);
            }
#undef RES_LOAD
        } else {
            const bf16_t* base = (const bf16_t*)base_lat;
            constexpr int AHB = 3;
            u32x4 bs[8][2];
#define RES_LOADB(R) do { const size_t off_ = RES_OFF(R); _Pragma("unroll") for (int bj = 0; bj < 2; ++bj) bs[R][bj] = *(const u32x4*)(base + off_ + bj * HALF); } while (0)
#pragma unroll
            for (int R = 0; R < AHB; ++R) RES_LOADB(R);
            __builtin_amdgcn_sched_barrier(0);
#pragma unroll
            for (int R = 0; R < 8; ++R) { if (R + AHB < 8) RES_LOADB(R + AHB);
                __builtin_amdgcn_sched_barrier(0);
                const size_t off = RES_OFF(R);
#pragma unroll
                for (int bj = 0; bj < 2; ++bj) { const u32x4 r = bs[R][bj];
                    const f32x4 b0 = (f32x4){__builtin_bit_cast(float, r.x << 16), __builtin_bit_cast(float, r.x & 0xffff0000u), __builtin_bit_cast(float, r.y << 16), __builtin_bit_cast(float, r.y & 0xffff0000u)};
                    const f32x4 b1 = (f32x4){__builtin_bit_cast(float, r.z << 16), __builtin_bit_cast(float, r.z & 0xffff0000u), __builtin_bit_cast(float, r.w << 16), __builtin_bit_cast(float, r.w & 0xffff0000u)};
                    const f32x4 o0 = b0 + gv[bj][0] * acc[R >> 2][bj][R & 3][0], o1 = b1 + gv[bj][1] * acc[R >> 2][bj][R & 3][1];
                    u32x4 w; w.x = cvt_pk_bf16(o0[0], o0[1]); w.y = cvt_pk_bf16(o0[2], o0[3]); w.z = cvt_pk_bf16(o1[0], o1[1]); w.w = cvt_pk_bf16(o1[2], o1[3]);
                    *(u32x4*)(out + off + bj * HALF) = w; }
                __builtin_amdgcn_sched_barrier(0);
            }
        }
#undef RES_LOADB
#undef RES_OFF
    }
};
struct EpiWin {
    static constexpr bool PERM = true;
    unsigned char* wsb; const float* rc; const float* rs;
    __device__ __forceinline__ void operator()(const f32x4 (&acc)[2][2][4][2], const Unit& u, int wr, int wc, int fr, int fq) const {
        const int row0 = u.pm * BM + wr * 64 + fr;
        const int ty = u.ty;
        if (ty == 0 || ty == 1 || (ty == 5 && u.pn < 4)) {
            const int hsel = wc >> 1, j0 = 32 * (wc & 1) + 8 * fq;
            const float sc = (ty == 0) ? 1.0f : 0.08838834764831845f;
            bf16_t* dst = (bf16_t*)(wsb + ((ty == 5) ? WS_KVC : WS_QKVG)); const int ld = (ty == 5) ? 2048 : 4096;
            const int cbase = u.pn * BM + hsel * 128 + j0;
#pragma unroll
            for (int ai = 0; ai < 2; ++ai)
#pragma unroll
                for (int m = 0; m < 4; ++m) {
                    const int r = row0 + ai * HALF + m * 16;
                    f32x4 c0 = (f32x4){1.f, 1.f, 1.f, 1.f}, c1 = c0, s0 = (f32x4){0.f, 0.f, 0.f, 0.f}, s1 = s0;
                    if (ty != 5) { const size_t ti = (size_t)(r & 4095) * 64 + j0; c0 = *(const f32x4*)(rc + ti); c1 = *(const f32x4*)(rc + ti + 4); s0 = *(const f32x4*)(rs + ti); s1 = *(const f32x4*)(rs + ti + 4); }
                    const f32x4 x10 = acc[ai][0][m][0] * sc, x11 = acc[ai][0][m][1] * sc, x20 = acc[ai][1][m][0] * sc, x21 = acc[ai][1][m][1] * sc;
                    const f32x4 o10 = x10 * c0 - x20 * s0, o11 = x11 * c1 - x21 * s1, o20 = x20 * c0 + x10 * s0, o21 = x21 * c1 + x11 * s1;
                    u32x4 w1, w2;
                    w1.x = cvt_pk_bf16(o10[0], o10[1]); w1.y = cvt_pk_bf16(o10[2], o10[3]); w1.z = cvt_pk_bf16(o11[0], o11[1]); w1.w = cvt_pk_bf16(o11[2], o11[3]);
                    w2.x = cvt_pk_bf16(o20[0], o20[1]); w2.y = cvt_pk_bf16(o20[2], o20[3]); w2.z = cvt_pk_bf16(o21[0], o21[1]); w2.w = cvt_pk_bf16(o21[2], o21[3]);
                    bf16_t* p = dst + (size_t)r * ld + cbase;
                    *(u32x4*)p = w1; *(u32x4*)(p + 64) = w2;
                }
        } else {
            bf16_t* dst = (bf16_t*)(wsb + ((ty == 4) ? WS_PHT : (ty == 5 ? WS_KVC : WS_QKVG))); const int ld = (ty == 4) ? 16384 : (ty == 5 ? 2048 : 4096);
            const int col0 = u.pn * BM + wc * 32 + 8 * fq;
#pragma unroll
            for (int ai = 0; ai < 2; ++ai)
#pragma unroll
                for (int m = 0; m < 4; ++m) { bf16_t* rowp = dst + (size_t)(row0 + ai * HALF + m * 16) * ld + col0;
#pragma unroll
                    for (int bj = 0; bj < 2; ++bj) { f32x4 v0 = acc[ai][bj][m][0], v1 = acc[ai][bj][m][1];
                        if (ty == 3) { v0 = (f32x4){silu_f(v0[0]), silu_f(v0[1]), silu_f(v0[2]), silu_f(v0[3])}; v1 = (f32x4){silu_f(v1[0]), silu_f(v1[1]), silu_f(v1[2]), silu_f(v1[3])}; }
                        u32x4 w; w.x = cvt_pk_bf16(v0[0], v0[1]); w.y = cvt_pk_bf16(v0[2], v0[3]); w.z = cvt_pk_bf16(v1[0], v1[1]); w.w = cvt_pk_bf16(v1[2], v1[3]);
                        *(u32x4*)(rowp + bj * HALF) = w; } }
        }
    }
};

template <class Epi, class Sched, bool ALIGN_EPI = false, bool SP2 = false, bool F8 = false>
__device__ __forceinline__ void gemm_phase(PG8_LAS unsigned char* lds, const Gemm g, const Sched& S, const Epi& E) {
    const int tid = threadIdx.x, wid = __builtin_amdgcn_readfirstlane(tid >> 6), lane = tid & 63, wr = wid >> 2, wc = wid & 3, fr = lane & 15, fq = lane >> 4;
    const int K = g.K, nt = K / BK;
    unsigned voffA[2], voffB[2];
#pragma unroll
    for (int i = 0; i < 2; ++i) { int R, C; stage_rc(tid * 16 + i * 8192, R, C); const int Rb = Epi::PERM ? ((R & ~31) + perm32(R & 31)) : R;
        voffA[i] = (unsigned)(R * g.lda + C) * 2u; voffB[i] = (unsigned)(Rb * g.ldb + C) * 2u; }
    const size_t kstep = (size_t)(BK * 2);
    const size_t hsA = (size_t)HALF * g.lda * 2, hsB = (size_t)HALF * g.ldb * 2;
    const unsigned ldsw = (unsigned)wid * 1024u;
    const int aoff = lds_byte(wr * 64 + fr, fq * 8), boff = lds_byte(wc * 32 + fr, fq * 8);
    const int a8o0 = lds_byte(wr * 64 + fr, 16 * fq + 8 * (fq & 1)), a8o1 = lds_byte(wr * 64 + fr, 16 * fq + 8 * (1 - (fq & 1)));
    const int b8o0 = lds_byte(wc * 32 + fr, 16 * fq + 8 * (fq & 1)), b8o1 = lds_byte(wc * 32 + fr, 16 * fq + 8 * (1 - (fq & 1)));
#define PG8_LDA8(dst, b, h) do { _Pragma("unroll") for (int m = 0; m < 4; ++m) { const i32x4 lo_ = *(const PG8_LAS i32x4*)(lds + PG8_SA(b, h) + a8o0 + m * 2048), hi_ = *(const PG8_LAS i32x4*)(lds + PG8_SA(b, h) + a8o1 + m * 2048); \
        dst[m] = __builtin_shufflevector(lo_, hi_, 0, 1, 2, 3, 4, 5, 6, 7); } } while (0)
#define PG8_LDB8(dst, b, h) do { _Pragma("unroll") for (int n = 0; n < 2; ++n) { const i32x4 lo_ = *(const PG8_LAS i32x4*)(lds + PG8_SB(b, h) + b8o0 + n * 2048), hi_ = *(const PG8_LAS i32x4*)(lds + PG8_SB(b, h) + b8o1 + n * 2048); \
        dst[n] = __builtin_shufflevector(lo_, hi_, 0, 1, 2, 3, 4, 5, 6, 7); } } while (0)
#define PG8_MMA8(ai, bj, At, Bt) do { __builtin_amdgcn_s_setprio(1); _Pragma("unroll") for (int m = 0; m < 4; ++m) _Pragma("unroll") for (int n = 0; n < 2; ++n) \
        asm volatile("v_mfma_scale_f32_16x16x128_f8f6f4 %0, %1, %2, %0, %3, %3 op_sel_hi:[0,0,0]" : "+v"(acc[ai][bj][m][n]) : "v"(Bt[n]), "v"(At[m]), "v"(f8scale)); __builtin_amdgcn_s_setprio(0); } while (0)
#define PG8_SA(b, h) (((b) * 2 + (h)) * HTB)
#define PG8_SB(b, h) ((4 + (b) * 2 + (h)) * HTB)
#define PG8_STAGE(bufoff, gbase, voff) do { _Pragma("unroll") for (int _i = 0; _i < 2; ++_i) \
        __builtin_amdgcn_global_load_lds((const unsigned*)((const char*)(gbase) + (voff)[_i]), (PG8_LAS unsigned*)(lds + (bufoff) + ldsw + _i * 8192), 16, 0, 0); } while (0)
#define PG8_LDA(dst, b, h) do { _Pragma("unroll") for (int m = 0; m < 4; ++m) _Pragma("unroll") for (int k = 0; k < 2; ++k) dst[m][k] = *(const PG8_LAS bf16x8*)(lds + PG8_SA(b, h) + aoff + m * 2048 + k * 1024); } while (0)
#define PG8_LDB(dst, b, h) do { _Pragma("unroll") for (int n = 0; n < 2; ++n) _Pragma("unroll") for (int k = 0; k < 2; ++k) dst[n][k] = *(const PG8_LAS bf16x8*)(lds + PG8_SB(b, h) + boff + n * 2048 + k * 1024); } while (0)
#define PG8_MMA(ai, bj, At, Bt) do { __builtin_amdgcn_s_setprio(1); _Pragma("unroll") for (int m = 0; m < 4; ++m) _Pragma("unroll") for (int n = 0; n < 2; ++n) _Pragma("unroll") for (int k = 0; k < 2; ++k) \
        acc[ai][bj][m][n] = __builtin_amdgcn_mfma_f32_16x16x32_bf16(Bt[n][k], At[m][k], acc[ai][bj][m][n], 0, 0, 0); __builtin_amdgcn_s_setprio(0); } while (0)
#define PG8_WAIT_V(n) asm volatile("s_waitcnt vmcnt(" #n ")" ::: "memory")
#define PG8_WAIT_L(n) asm volatile("s_waitcnt lgkmcnt(" #n ")" ::: "memory")
#define PG8_BAR __builtin_amdgcn_s_barrier()
#define PG8_SCHED __builtin_amdgcn_sched_barrier(0)
    Unit cur, nxt; int ui = 0;
    if (!S.next(0, cur)) return;
    f32x4 acc[2][2][4][2];
#pragma unroll
    for (int a = 0; a < 2; ++a)
#pragma unroll
        for (int b = 0; b < 2; ++b)
#pragma unroll
            for (int m = 0; m < 4; ++m)
#pragma unroll
                for (int n = 0; n < 2; ++n) acc[a][b][m][n] = (f32x4){0.f, 0.f, 0.f, 0.f};
    bf16x8 At[4][2], B0[2][2], B1[2][2];
    i32x8 At8[4], B08[2], B18[2];
    int f8scale = 0x7f7f7f7f; asm volatile("" : "+v"(f8scale));
    const char* cA = cur.A; const char* cB = cur.B;
    if constexpr (SP2) {
        PG8_STAGE(PG8_SB(0, 0), cB, voffB); PG8_STAGE(PG8_SB(0, 1), cB + hsB, voffB); PG8_STAGE(PG8_SA(0, 0), cA, voffA); PG8_STAGE(PG8_SA(0, 1), cA + hsA, voffA);
        if (wr == 1) PG8_BAR;
        PG8_WAIT_V(2); PG8_BAR;
        PG8_STAGE(PG8_SB(1, 0), cB + kstep, voffB); PG8_STAGE(PG8_SA(1, 0), cA + kstep, voffA); PG8_STAGE(PG8_SB(1, 1), cB + hsB + kstep, voffB);
        PG8_WAIT_V(6); PG8_BAR;
    } else {
        PG8_STAGE(PG8_SB(0, 0), cB, voffB); PG8_STAGE(PG8_SA(0, 0), cA, voffA); PG8_STAGE(PG8_SB(0, 1), cB + hsB, voffB); PG8_STAGE(PG8_SA(0, 1), cA + hsA, voffA);
        if (wr == 1) PG8_BAR;
        PG8_WAIT_V(4); PG8_BAR;
        PG8_STAGE(PG8_SB(1, 0), cB + kstep, voffB); PG8_STAGE(PG8_SA(1, 0), cA + kstep, voffA); PG8_STAGE(PG8_SB(1, 1), cB + hsB + kstep, voffB);
        PG8_WAIT_V(6); PG8_BAR;
    }
    for (;;) {
        const bool has_next = S.next(ui + 1, nxt);
        const char* nA = has_next ? nxt.A : cA; const char* nB = has_next ? nxt.B : cB;
        for (int t = 0; t < nt; t += 2) {
            const bool last = (t == nt - 2);
            const char* a1 = cA + (size_t)(t + 1) * kstep;
            const char* a2 = last ? nA : cA + (size_t)(t + 2) * kstep; const char* b2 = last ? nB : cB + (size_t)(t + 2) * kstep;
            const char* a3 = a2 + kstep; const char* b3 = b2 + kstep;
            if constexpr (SP2 && F8) {
            PG8_LDB8(B08, 0, 0); PG8_LDB8(B18, 0, 1); PG8_SCHED; PG8_LDA8(At8, 0, 0); PG8_STAGE(PG8_SA(1, 1), a1 + hsA, voffA);
            PG8_WAIT_V(8); PG8_WAIT_L(0); PG8_BAR; PG8_MMA8(0, 0, At8, B08); PG8_MMA8(0, 1, At8, B18); PG8_BAR; PG8_SCHED;
            PG8_LDA8(At8, 0, 1); PG8_STAGE(PG8_SB(0, 0), b2, voffB); PG8_STAGE(PG8_SB(0, 1), b2 + hsB, voffB); PG8_STAGE(PG8_SA(0, 0), a2, voffA);
            PG8_WAIT_V(8); PG8_WAIT_L(0); PG8_BAR; PG8_MMA8(1, 0, At8, B08); PG8_MMA8(1, 1, At8, B18); PG8_BAR; PG8_SCHED;
            PG8_LDB8(B08, 1, 0); PG8_LDB8(B18, 1, 1); PG8_SCHED; PG8_LDA8(At8, 1, 0); PG8_STAGE(PG8_SA(0, 1), a2 + hsA, voffA);
            PG8_WAIT_V(8); PG8_WAIT_L(0); PG8_BAR; PG8_MMA8(0, 0, At8, B08); PG8_MMA8(0, 1, At8, B18); PG8_BAR; PG8_SCHED;
            PG8_LDA8(At8, 1, 1); PG8_STAGE(PG8_SB(1, 0), b3, voffB); PG8_STAGE(PG8_SB(1, 1), b3 + hsB, voffB); PG8_STAGE(PG8_SA(1, 0), a3, voffA);
            PG8_WAIT_V(8); PG8_WAIT_L(0); PG8_BAR; PG8_MMA8(1, 0, At8, B08); PG8_MMA8(1, 1, At8, B18); PG8_BAR; PG8_SCHED;
            } else if constexpr (SP2) {
            PG8_LDB(B0, 0, 0); PG8_LDB(B1, 0, 1); PG8_SCHED; PG8_LDA(At, 0, 0); PG8_STAGE(PG8_SA(1, 1), a1 + hsA, voffA);
            PG8_WAIT_V(8); PG8_WAIT_L(0); PG8_BAR; PG8_MMA(0, 0, At, B0); PG8_MMA(0, 1, At, B1); PG8_BAR; PG8_SCHED;
            PG8_LDA(At, 0, 1); PG8_STAGE(PG8_SB(0, 0), b2, voffB); PG8_STAGE(PG8_SB(0, 1), b2 + hsB, voffB); PG8_STAGE(PG8_SA(0, 0), a2, voffA);
            PG8_WAIT_V(8); PG8_WAIT_L(0); PG8_BAR; PG8_MMA(1, 0, At, B0); PG8_MMA(1, 1, At, B1); PG8_BAR; PG8_SCHED;
            PG8_LDB(B0, 1, 0); PG8_LDB(B1, 1, 1); PG8_SCHED; PG8_LDA(At, 1, 0); PG8_STAGE(PG8_SA(0, 1), a2 + hsA, voffA);
            PG8_WAIT_V(8); PG8_WAIT_L(0); PG8_BAR; PG8_MMA(0, 0, At, B0); PG8_MMA(0, 1, At, B1); PG8_BAR; PG8_SCHED;
            PG8_LDA(At, 1, 1); PG8_STAGE(PG8_SB(1, 0), b3, voffB); PG8_STAGE(PG8_SB(1, 1), b3 + hsB, voffB); PG8_STAGE(PG8_SA(1, 0), a3, voffA);
            PG8_WAIT_V(8); PG8_WAIT_L(0); PG8_BAR; PG8_MMA(1, 0, At, B0); PG8_MMA(1, 1, At, B1); PG8_BAR; PG8_SCHED;
            } else {
            PG8_LDB(B0, 0, 0); PG8_SCHED; PG8_LDA(At, 0, 0); PG8_STAGE(PG8_SA(1, 1), a1 + hsA, voffA);
            PG8_WAIT_L(8); PG8_BAR; PG8_WAIT_L(0); PG8_MMA(0, 0, At, B0); PG8_BAR; PG8_SCHED;
            PG8_LDB(B1, 0, 1); PG8_STAGE(PG8_SB(0, 0), b2, voffB);
            PG8_BAR; PG8_WAIT_L(0); PG8_MMA(0, 1, At, B1); PG8_BAR;
            PG8_LDA(At, 0, 1); PG8_STAGE(PG8_SA(0, 0), a2, voffA);
            PG8_BAR; PG8_WAIT_L(0); PG8_MMA(1, 0, At, B0); PG8_BAR; PG8_SCHED;
            PG8_STAGE(PG8_SB(0, 1), b2 + hsB, voffB);
            PG8_WAIT_V(6); PG8_BAR; PG8_MMA(1, 1, At, B1); PG8_BAR;
            PG8_LDB(B0, 1, 0); PG8_SCHED; PG8_LDA(At, 1, 0); PG8_STAGE(PG8_SA(0, 1), a2 + hsA, voffA);
            PG8_WAIT_L(8); PG8_BAR; PG8_WAIT_L(0); PG8_MMA(0, 0, At, B0); PG8_BAR; PG8_SCHED;
            PG8_LDB(B1, 1, 1); PG8_STAGE(PG8_SB(1, 0), b3, voffB);
            PG8_BAR; PG8_WAIT_L(0); PG8_MMA(0, 1, At, B1); PG8_BAR;
            PG8_LDA(At, 1, 1); PG8_STAGE(PG8_SA(1, 0), a3, voffA);
            PG8_BAR; PG8_WAIT_L(0); PG8_MMA(1, 0, At, B0); PG8_BAR; PG8_SCHED;
            PG8_STAGE(PG8_SB(1, 1), b3 + hsB, voffB);
            PG8_WAIT_V(6); PG8_BAR; PG8_MMA(1, 1, At, B1); PG8_BAR;
            }
        }
        if constexpr (ALIGN_EPI) { if (wr == 0) PG8_BAR; }
        if constexpr (F8) asm volatile("s_nop 15\n\ts_nop 15" ::: "memory");
        E(acc, cur, wr, wc, fr, fq);
        if (!has_next) break;
#pragma unroll
        for (int a = 0; a < 2; ++a)
#pragma unroll
            for (int b = 0; b < 2; ++b)
#pragma unroll
                for (int m = 0; m < 4; ++m)
#pragma unroll
                    for (int n = 0; n < 2; ++n) acc[a][b][m][n] = (f32x4){0.f, 0.f, 0.f, 0.f};
        cur = nxt; cA = nA; cB = nB; ++ui;
        if constexpr (ALIGN_EPI) { if (wr == 1) PG8_BAR; }
    }
    PG8_WAIT_V(0);
    if constexpr (!ALIGN_EPI) { if (wr == 0) PG8_BAR; }
    PG8_BAR;
#undef PG8_LDA8
#undef PG8_LDB8
#undef PG8_MMA8
#undef PG8_SA
#undef PG8_SB
#undef PG8_STAGE
#undef PG8_LDA
#undef PG8_LDB
#undef PG8_MMA
#undef PG8_WAIT_V
#undef PG8_WAIT_L
#undef PG8_BAR
#undef PG8_SCHED
}
}

constexpr int LDS_BYTES = 147456;
constexpr int MISC_OFF = LDS_BYTES - 256;

#define GAS __attribute__((address_space(1)))
#define LAS __attribute__((address_space(3)))
typedef unsigned short bf16;
typedef unsigned v4u __attribute__((ext_vector_type(4)));
typedef unsigned v2u __attribute__((ext_vector_type(2)));
typedef float f32x4 __attribute__((ext_vector_type(4)));
typedef short bf16x8 __attribute__((ext_vector_type(8)));
typedef short s16x4 __attribute__((ext_vector_type(4)));
typedef GAS unsigned gu32;
#define RLX_AGENT __ATOMIC_RELAXED, __HIP_MEMORY_SCOPE_AGENT
#define LDS_WAIT() asm volatile("s_waitcnt lgkmcnt(0)" ::: "memory")
#define LDS_BARRIER() asm volatile("s_waitcnt lgkmcnt(0)\n\ts_barrier" ::: "memory")
#define VM_WAIT() asm volatile("s_waitcnt vmcnt(0)" ::: "memory")
__device__ __forceinline__ unsigned pk2(float lo, float hi) { unsigned r; asm("v_cvt_pk_bf16_f32 %0, %1, %2" : "=v"(r) : "v"(lo), "v"(hi)); return r; }
__device__ __forceinline__ unsigned f2bf(float f) { return pk2(f, 0.0f) & 0xffffu; }
__device__ __forceinline__ float bf2f(unsigned short b) { return __builtin_bit_cast(float, (unsigned)b << 16); }
__device__ __forceinline__ float bflo(unsigned w) { return __builtin_bit_cast(float, w << 16); }
__device__ __forceinline__ float bfhi(unsigned w) { return __builtin_bit_cast(float, w & 0xffff0000u); }
__device__ __forceinline__ float fexp(float x) { return __builtin_amdgcn_exp2f(x * 1.44269504089f); }
__device__ __forceinline__ float wave_sum(float v) {
#pragma unroll
    for (int o = 1; o < 64; o <<= 1) v += __shfl_xor(v, o);
    return v;
}

#define XB_TMO      128
#define XB_XCNT(j)  (256  + 64 * (j))
#define XB_XSUB(j)  (1280 + 64 * (j))
#define XB_XGEN(j)  (2304 + 64 * (j))
#define XB_TOP      3328
#define XB_TOPGEN   3392
#define XCD_BAR_WORDS 3456
#define XB_SPIN_CAP (1u << 21)
__device__ __forceinline__ unsigned xb_ld(unsigned* p)              { return __hip_atomic_load(p, __ATOMIC_RELAXED, __HIP_MEMORY_SCOPE_AGENT); }
__device__ __forceinline__ unsigned xb_add(unsigned* p, unsigned v) { return __hip_atomic_fetch_add(p, v, __ATOMIC_RELAXED, __HIP_MEMORY_SCOPE_AGENT); }
__device__ __forceinline__ unsigned xb_xcc_id() { return (unsigned)__builtin_amdgcn_s_getreg((3 << 11) | 20) & 0xFu; }
#define XB_SPIN(cond, bar) do { unsigned _sp = 0; while (cond) { __builtin_amdgcn_s_sleep(1); \
    if ((++_sp & 255u) == 0u) { if (xb_ld(&(bar)[XB_TMO])) break; if (_sp > XB_SPIN_CAP) { atomicAdd(&(bar)[XB_TMO], 1u); break; } } } } while (0)
struct XcdBarrier { unsigned* bar; unsigned x; volatile LAS unsigned* st; };
__device__ __forceinline__ XcdBarrier xcd_barrier_post(unsigned* bar, volatile LAS unsigned* st) {
    XcdBarrier b; b.bar = bar; b.x = xb_xcc_id(); b.st = st;
    if (threadIdx.x == 0) (void)xb_add(&bar[XB_XCNT(b.x)], 1u);
    return b;
}
__device__ __forceinline__ void xcd_barrier_complete(unsigned* bar, unsigned x, unsigned& nloc, unsigned& nx) {
    const unsigned G = gridDim.x * gridDim.y * gridDim.z;
    unsigned sum, cnt, mine, sp = 0u;
    for (;;) {
        sum = 0u; cnt = 0u; mine = 0u;
#pragma unroll
        for (unsigned j = 0; j < 16; ++j) { const unsigned c = xb_ld(&bar[XB_XCNT(j)]); sum += c; cnt += (c > 0u) ? 1u : 0u; mine = (j == x) ? c : mine; }
        if (sum == G) break;
        __builtin_amdgcn_s_sleep(1);
        if ((++sp & 255u) == 0u) { if (xb_ld(&bar[XB_TMO])) break; if (sp > XB_SPIN_CAP) { atomicAdd(&bar[XB_TMO], 1u); break; } }
    }
    nloc = mine > 0u ? mine : 1u; nx = cnt > 0u ? cnt : 1u;
}
__device__ __forceinline__ void xcd_barrier(const XcdBarrier& b) {
    asm volatile("s_waitcnt vmcnt(0)" ::: "memory");
    __syncthreads();
    if (threadIdx.x == 0) {
        unsigned* bar = b.bar;
        __builtin_amdgcn_s_waitcnt(0);
        unsigned nloc = b.st[0], nx = b.st[1];
        if (nloc == 0u) { xcd_barrier_complete(bar, b.x, nloc, nx); b.st[0] = nloc; b.st[1] = nx; }
        const unsigned old = xb_add(&bar[XB_XSUB(b.x)], 1u);
        const unsigned gen = old / nloc;
        if (old + 1u == (gen + 1u) * nloc) {
            __builtin_amdgcn_fence(__ATOMIC_RELEASE, "agent");
            asm volatile("s_waitcnt vmcnt(0)" ::: "memory");
            const unsigned og = xb_add(&bar[XB_TOP], 1u);
            const unsigned tg = og / nx;
            if (og + 1u == (tg + 1u) * nx) xb_add(&bar[XB_TOPGEN], 1u);
            else XB_SPIN(xb_ld(&bar[XB_TOPGEN]) == tg, bar);
            __builtin_amdgcn_fence(__ATOMIC_ACQUIRE, "agent");
            xb_add(&bar[XB_XGEN(b.x)], 1u);
            asm volatile("s_waitcnt vmcnt(0)" ::: "memory");
        } else {
            XB_SPIN(xb_ld(&bar[XB_XGEN(b.x)]) == gen, bar);
            __builtin_amdgcn_fence(__ATOMIC_ACQUIRE, "agent");
            asm volatile("s_waitcnt vmcnt(0)" ::: "memory");
        }
    }
    __syncthreads();
}

struct Args { const float* in[29]; float* out; unsigned char* ws; int ph_lo, ph_hi; };
enum { I_X = 0, I_C, I_CTX, I_CCTX, I_WMOD, I_BMOD, I_F1W1, I_F1W3, I_F1W2, I_F2W1, I_F2W3, I_F2W2, I_WIN, I_WOUT, I_LOGD, I_CONVW, I_CONVB,
       I_FW1, I_FB1, I_FW2, I_FB2, I_FW3, I_FB3, I_FREQ, I_FW4, I_HYB, I_POOLW, I_POOLS, I_FGAIN };

struct Frame {
    LAS unsigned char* lds;
    int tid, lane, wave, G, gw, NGW;
};

__device__ __forceinline__ void conv_item(const float* W, int N, bf16* WT, int K, int k0, int n0, int drow, int lane) {
    const float* p = W + (size_t)k0 * N + n0 + lane;
    float v[64];
#pragma unroll
    for (int i = 0; i < 64; ++i) v[i] = __builtin_nontemporal_load((const GAS float*)(p + (size_t)i * N));
    bf16* o = WT + (size_t)drow * K + k0;
#pragma unroll
    for (int q = 0; q < 8; ++q) { v4u w; w.x = pk2(v[8 * q], v[8 * q + 1]); w.y = pk2(v[8 * q + 2], v[8 * q + 3]); w.z = pk2(v[8 * q + 4], v[8 * q + 5]); w.w = pk2(v[8 * q + 6], v[8 * q + 7]);
        *(GAS v4u*)(o + 8 * q) = w; }
}
__device__ __forceinline__ void conv_item8(const float* W, int N, unsigned char* WT, int Kb, int k0, int n0, int drow, float scale, int lane) {
    const float* p = W + (size_t)k0 * N + n0 + lane;
    float v[64];
#pragma unroll
    for (int i = 0; i < 64; ++i) v[i] = __builtin_nontemporal_load((const GAS float*)(p + (size_t)i * N));
    unsigned char* o = WT + (size_t)drow * Kb + k0;
#pragma unroll
    for (int q = 0; q < 4; ++q) { v4u w;
        w.x = pg8::pack4_fp8(v[16 * q] * scale, v[16 * q + 1] * scale, v[16 * q + 2] * scale, v[16 * q + 3] * scale); w.y = pg8::pack4_fp8(v[16 * q + 4] * scale, v[16 * q + 5] * scale, v[16 * q + 6] * scale, v[16 * q + 7] * scale);
        w.z = pg8::pack4_fp8(v[16 * q + 8] * scale, v[16 * q + 9] * scale, v[16 * q + 10] * scale, v[16 * q + 11] * scale); w.w = pg8::pack4_fp8(v[16 * q + 12] * scale, v[16 * q + 13] * scale, v[16 * q + 14] * scale, v[16 * q + 15] * scale);
        *(GAS v4u*)(o + 16 * q) = w; }
}

__device__ __forceinline__ f32x4 mod_from_partials(const float* modp, const float* bmod, int layer, int r, int col) {
    f32x4 s = *(const f32x4*)(bmod + (size_t)layer * MODW + col);
#pragma unroll 4
    for (int ks = 0; ks < KS_MOD; ++ks) s += *(const f32x4*)(modp + ((size_t)((ks * 2 + layer) * 5 + r)) * MODW + col);
    return s;
}

__device__ __forceinline__ void norm_pass(Frame& F, const float* src_lat, const float* src_ctx, int nrows, const float* mod, const float* modp, const float* bmod, int layer, int j, bf16* HNo, bool f8out) {
    LAS float* SS = (LAS float*)F.lds;
    const int per = nrows / F.G, rbeg = blockIdx.x * per, rend = rbeg + per;
    int sbeg = rbeg;
    while (sbeg < rend) {
        const int rb = sbeg < ML ? sbeg / SEQ : 4;
        int send = sbeg < ML ? (rb + 1) * SEQ : rend; if (send > rend) send = rend;
        __syncthreads();
        for (int c4 = F.tid; c4 < 2 * DM / 4; c4 += NTHR) { const int which = c4 / (DM / 4), col = (c4 % (DM / 4)) * 4;
            f32x4 v = modp ? mod_from_partials(modp, bmod, layer, rb, (j + which) * DM + col) : *(const f32x4*)(mod + ((size_t)(layer * 5 + rb) * 9 + j + which) * DM + col);
            *(LAS f32x4*)(SS + which * DM + col) = v; }
        __syncthreads();
        int row = sbeg + F.wave;
        f32x4 vn[8];
        if (row < send) { const float* xr = row < ML ? src_lat + (size_t)row * DM : src_ctx + (size_t)(row - ML) * DM;
#pragma unroll
            for (int q = 0; q < 8; ++q) vn[q] = *(const GAS f32x4*)(xr + 4 * F.lane + 256 * q); }
        while (row < send) {
            f32x4 v[8]; float s2 = 0.f;
#pragma unroll
            for (int q = 0; q < 8; ++q) v[q] = vn[q];
            const int rn = row + NWAVES;
            if (rn < send) { const float* xr = rn < ML ? src_lat + (size_t)rn * DM : src_ctx + (size_t)(rn - ML) * DM;
#pragma unroll
                for (int q = 0; q < 8; ++q) vn[q] = *(const GAS f32x4*)(xr + 4 * F.lane + 256 * q); }
#pragma unroll
            for (int q = 0; q < 8; ++q) s2 += (v[q].x * v[q].x + v[q].y * v[q].y) + (v[q].z * v[q].z + v[q].w * v[q].w);
            const float rstd = 1.0f / sqrtf(wave_sum(s2) * (1.0f / DM) + 1e-6f);
            bf16* orow = HNo + (size_t)row * DM;
#pragma unroll
            for (int q = 0; q < 8; ++q) { const int col = 4 * F.lane + 256 * q; const f32x4 sh = *(const LAS f32x4*)(SS + col), sc = *(const LAS f32x4*)(SS + DM + col);
                const f32x4 o = v[q] * rstd * (sc + 1.0f) + sh;
                if (f8out) { *(GAS unsigned*)((unsigned char*)HNo + (size_t)row * DM + col) = pg8::pack4_fp8(o.x * pg8::F8S_ACT, o.y * pg8::F8S_ACT, o.z * pg8::F8S_ACT, o.w * pg8::F8S_ACT); }
                else { v2u w; w.x = pk2(o.x, o.y); w.y = pk2(o.z, o.w); *(GAS v2u*)(orow + col) = w; } }
            row = rn;
        }
        sbeg = send;
    }
    __syncthreads();
}

__device__ __forceinline__ void norm_pass_h(Frame& F, const bf16* XHs, int nrows, const float* mod, int layer, int j, bf16* HNo, bool f8out, const float* modp = nullptr, const float* bmod = nullptr) {
    LAS float* SS = (LAS float*)F.lds;
    const int per = nrows / F.G, rbeg = blockIdx.x * per, rend = rbeg + per;
    int sbeg = rbeg;
    while (sbeg < rend) {
        const int rb = sbeg < ML ? sbeg / SEQ : 4;
        int send = sbeg < ML ? (rb + 1) * SEQ : rend; if (send > rend) send = rend;
        __syncthreads();
        for (int c4 = F.tid; c4 < 2 * DM / 4; c4 += NTHR) { const int which = c4 / (DM / 4), col = (c4 % (DM / 4)) * 4;
            *(LAS f32x4*)(SS + which * DM + col) = modp ? mod_from_partials(modp, bmod, layer, rb, (j + which) * DM + col) : *(const f32x4*)(mod + ((size_t)(layer * 5 + rb) * 9 + j + which) * DM + col); }
        __syncthreads();
        int row = sbeg + F.wave;
        v4u vn[4];
        if (row < send) {
#pragma unroll
            for (int q = 0; q < 4; ++q) vn[q] = *(const GAS v4u*)(XHs + (size_t)row * DM + 8 * F.lane + 512 * q); }
        while (row < send) {
            v4u v[4]; float s2 = 0.f;
#pragma unroll
            for (int q = 0; q < 4; ++q) v[q] = vn[q];
            const int rn = row + NWAVES;
            if (rn < send) {
#pragma unroll
                for (int q = 0; q < 4; ++q) vn[q] = *(const GAS v4u*)(XHs + (size_t)rn * DM + 8 * F.lane + 512 * q); }
            f32x4 x0[4], x1[4];
#pragma unroll
            for (int q = 0; q < 4; ++q) { x0[q] = (f32x4){bflo(v[q].x), bfhi(v[q].x), bflo(v[q].y), bfhi(v[q].y)}; x1[q] = (f32x4){bflo(v[q].z), bfhi(v[q].z), bflo(v[q].w), bfhi(v[q].w)};
                s2 += ((x0[q].x * x0[q].x + x0[q].y * x0[q].y) + (x0[q].z * x0[q].z + x0[q].w * x0[q].w)) + ((x1[q].x * x1[q].x + x1[q].y * x1[q].y) + (x1[q].z * x1[q].z + x1[q].w * x1[q].w)); }
            const float rstd = 1.0f / sqrtf(wave_sum(s2) * (1.0f / DM) + 1e-6f);
#pragma unroll
            for (int q = 0; q < 4; ++q) { const int col = 8 * F.lane + 512 * q;
                const f32x4 o0 = x0[q] * rstd * (*(const LAS f32x4*)(SS + DM + col) + 1.0f) + *(const LAS f32x4*)(SS + col);
                const f32x4 o1 = x1[q] * rstd * (*(const LAS f32x4*)(SS + DM + col + 4) + 1.0f) + *(const LAS f32x4*)(SS + col + 4);
                if (f8out) { v2u w; w.x = pg8::pack4_fp8(o0.x * pg8::F8S_ACT, o0.y * pg8::F8S_ACT, o0.z * pg8::F8S_ACT, o0.w * pg8::F8S_ACT); w.y = pg8::pack4_fp8(o1.x * pg8::F8S_ACT, o1.y * pg8::F8S_ACT, o1.z * pg8::F8S_ACT, o1.w * pg8::F8S_ACT);
                    *(GAS v2u*)((unsigned char*)HNo + (size_t)row * DM + col) = w; }
                else { v4u w; w.x = pk2(o0.x, o0.y); w.y = pk2(o0.z, o0.w); w.z = pk2(o1.x, o1.y); w.w = pk2(o1.z, o1.w); *(GAS v4u*)(HNo + (size_t)row * DM + col) = w; } }
            row = rn;
        }
        sbeg = send;
    }
    __syncthreads();
}

__global__ void __launch_bounds__(NTHR, 2) mk_fwd(Args args) {
    extern __shared__ __attribute__((aligned(16))) unsigned char lds_raw[];
    Frame F;
    F.lds = (LAS unsigned char*)lds_raw;
    volatile LAS unsigned* MISC = (volatile LAS unsigned*)(F.lds + MISC_OFF);
    F.tid = threadIdx.x; F.lane = F.tid & 63; F.wave = __builtin_amdgcn_readfirstlane(F.tid >> 6);
    F.G = gridDim.x; F.gw = blockIdx.x * NWAVES + F.wave; F.NGW = F.G * NWAVES;
    unsigned char* ws = args.ws;
    gu32* ctl = (gu32*)(ws + WS_CTL);
    if (F.tid < 64) MISC[F.tid] = 0u;
    __syncthreads();
    XcdBarrier bar; bar.bar = (unsigned*)(ctl + CW_BAR); bar.x = 0; bar.st = nullptr;
    const int lo = args.ph_lo, hi = args.ph_hi;
    if (hi - lo > 1) bar = xcd_barrier_post((unsigned*)(ctl + CW_BAR), MISC + 8);
#define IN(k) (lo <= (k) && (k) < hi)
#define REP(k) for (int rep_ = 0; rep_ < ((DUP_PHASE) == (k) ? 2 : 1); ++rep_)
#define SEAM(k) do { if (IN(k) && IN((k) + 1)) xcd_barrier(bar); } while (0)

    float* modp = (float*)(ws + WS_MODP); float* mod = (float*)(ws + WS_MOD);
    float* A3 = (float*)(ws + WS_A3); float* rotc = (float*)(ws + WS_ROTC); float* rots = (float*)(ws + WS_ROTS);
    bf16* Wup = (bf16*)(ws + WS_WUP); bf16* Wdn = (bf16*)(ws + WS_WDN); bf16* Win = (bf16*)(ws + WS_WIN); bf16* Wout = (bf16*)(ws + WS_WOUT); bf16* Wpool = (bf16*)(ws + WS_WPOOL);
    bf16* XB = (bf16*)(ws + WS_X);
    bf16* HN = (bf16*)(ws + WS_HN); bf16* HID = (bf16*)(ws + WS_HID);
    bf16* QKVG = (bf16*)(ws + WS_QKVG); bf16* KVC = (bf16*)(ws + WS_KVC); bf16* YHT = (bf16*)(ws + WS_YHT); bf16* PHT = (bf16*)(ws + WS_PHT);
    bf16* SPREV = (bf16*)(ws + WS_SPREV); bf16* KR = (bf16*)(ws + WS_KR); bf16* TC = (bf16*)(ws + WS_TC); bf16* DD = (bf16*)(ws + WS_DD);
    bf16* A2 = HN;
    const size_t UPSZ = (size_t)NUP * DM, DNSZ = (size_t)DM * DFF;

    constexpr int NI_UP = 32 * 88, NI_DN = 88 * 32, NI_WIN = 32 * 112, NI_WOUT = 32 * 32, NI_POOL = 8 * 8;
    constexpr int CV_P0UP = 2 * NI_UP, CV_P0 = 2 * NI_UP + NI_DN, CV_N0 = 2 * NI_UP + NI_DN + NI_WOUT, CV_N1A = NI_WIN + 2 * NI_UP + NI_DN, CV_N1B = 2 * (2 * NI_UP + NI_DN) + 4 * NI_POOL;
#define CONVERT_ITEM(IT) do { int r = (IT); int kind = -1, m8 = 0, fd = 0; \
        if (r < 2 * NI_UP) { kind = 0; m8 = r / NI_UP; r %= NI_UP; } else { r -= 2 * NI_UP; \
        if (r < NI_DN) { kind = 1; fd = 0; } else { r -= NI_DN; \
        if (r < NI_WOUT) { kind = 3; } else { r -= NI_WOUT; \
        if (r < NI_WIN) { kind = 2; } else { r -= NI_WIN; \
        if (r < 2 * NI_UP) { kind = 0; m8 = 4 + r / NI_UP; r %= NI_UP; } else { r -= 2 * NI_UP; \
        if (r < NI_DN) { kind = 1; fd = 2; } else { r -= NI_DN; \
        if (r < 2 * NI_UP) { kind = 0; m8 = 2 + r / NI_UP; r %= NI_UP; } else { r -= 2 * NI_UP; \
        if (r < NI_DN) { kind = 1; fd = 1; } else { r -= NI_DN; \
        if (r < 2 * NI_UP) { kind = 0; m8 = 6 + r / NI_UP; r %= NI_UP; } else { r -= 2 * NI_UP; \
        if (r < NI_DN) { kind = 1; fd = 3; } else { r -= NI_DN; kind = 4; } } } } } } } } } } \
        if (kind == 0) { const int f = m8 >> 1, half = m8 & 1, kb = r / 88, nb = r % 88, n0 = nb * 64, n = n0 + F.lane, dr = (n >> 7) * 256 + half * 128 + (n & 127); \
            const float* src = args.in[(f & 1) ? (half ? I_F2W3 : I_F2W1) : (half ? I_F1W3 : I_F1W1)] + (size_t)(f >> 1) * DM * DFF; \
            if (F8_UP) conv_item8(src, DFF, (unsigned char*)(Wup + f * UPSZ), DM, kb * 64, n0, dr, pg8::F8S_WUP, F.lane); \
            else conv_item(src, DFF, Wup + f * UPSZ, DM, kb * 64, n0, dr, F.lane); } \
        else if (kind == 1) { const int kb = r / 32, nb = r % 32; const float* src = args.in[(fd & 1) ? I_F2W2 : I_F1W2] + (size_t)(fd >> 1) * DFF * DM; \
            if (F8_DN) conv_item8(src, DM, (unsigned char*)(Wdn + fd * DNSZ), DFF, kb * 64, nb * 64, nb * 64 + F.lane, pg8::F8S_WDN, F.lane); \
            else conv_item(src, DM, Wdn + fd * DNSZ, DFF, kb * 64, nb * 64, nb * 64 + F.lane, F.lane); } \
        else if (kind == 2) { const int kb = r / 112, nb = r % 112, n0 = nb * 64, n = n0 + F.lane; int dr = n; \
            if (n0 < 2048) { const int tile = n >> 8, hsel = (n >> 7) & 1, jj = n & 127, bj = jj >> 6, j = jj & 63; dr = tile * 256 + bj * 128 + hsel * 64 + j; } \
            conv_item(args.in[I_WIN], NPROJ, Win, DM, kb * 64, n0, dr, F.lane); } \
        else if (kind == 3) { const int kb = r / 32, nb = r % 32; conv_item(args.in[I_WOUT], DM, Wout, DM, kb * 64, nb * 64, nb * 64 + F.lane, F.lane); } \
        else { const int g = r / NI_POOL, item = r % NI_POOL, kb = item / 8, nb = item % 8; \
            conv_item(args.in[I_POOLW] + (size_t)g * 512 * 512, 512, Wpool + (size_t)g * 512 * 512, 512, kb * 64, nb * 64, nb * 64 + F.lane, F.lane); } } while (0)
#define CONVERT_IN_TAIL(LO, N) do { if (blockIdx.x >= 32) { const int wk_ = ((int)blockIdx.x - 32) * NWAVES + F.wave, nwk_ = (F.G - 32) * NWAVES; \
        for (int it_ = wk_; it_ < (N); it_ += nwk_) CONVERT_ITEM((LO) + it_); } __syncthreads(); } while (0)

#define BUILD_SC() do { LAS float* SC_ = (LAS float*)(F.lds + 8 * 8704); \
        for (int i = F.tid; i < 5 * DM; i += NTHR) { const int r = i / DM, k = i % DM; const float cv = r < 4 ? args.in[I_C][r * DM + k] : args.in[I_CCTX][k]; SC_[i] = cv / (1.0f + expf(-cv)); } \
        __syncthreads(); } while (0)
#define GEMV_ITEM(LAYER, REM) do { const LAS float* SC_ = (const LAS float*)(F.lds + 8 * 8704); const int layer_ = (LAYER), ks_ = (REM) / 72, cb_ = (REM) % 72, col_ = cb_ * 256 + 4 * F.lane; \
        const float* wp_ = args.in[I_WMOD] + ((size_t)layer_ * DM + ks_ * 128) * MODW + col_; \
        f32x4 a0 = {0, 0, 0, 0}, a1 = a0, a2 = a0, a3 = a0, a4 = a0; \
        _Pragma("unroll 1") for (int kb_ = 0; kb_ < 128; kb_ += GV_ROWS) { f32x4 w_[GV_ROWS]; \
            _Pragma("unroll") for (int q_ = 0; q_ < GV_ROWS; ++q_) w_[q_] = __builtin_nontemporal_load((const GAS f32x4*)(wp_ + (size_t)(kb_ + q_) * MODW)); \
            __builtin_amdgcn_sched_barrier(0); \
            _Pragma("unroll") for (int g_ = 0; g_ < GV_ROWS / 8; ++g_) { \
                _Pragma("unroll") for (int q_ = 8 * g_; q_ < 8 * g_ + 8; ++q_) { const int kk = ks_ * 128 + kb_ + q_; \
                    a0 += w_[q_] * SC_[kk]; a1 += w_[q_] * SC_[DM + kk]; a2 += w_[q_] * SC_[2 * DM + kk]; a3 += w_[q_] * SC_[3 * DM + kk]; a4 += w_[q_] * SC_[4 * DM + kk]; } \
                __builtin_amdgcn_sched_barrier(0); } } \
        float* op_ = modp + ((size_t)((ks_ * 2 + layer_) * 5)) * MODW + col_; \
        *(f32x4*)(op_) = a0; *(f32x4*)(op_ + MODW) = a1; *(f32x4*)(op_ + 2 * MODW) = a2; *(f32x4*)(op_ + 3 * MODW) = a3; *(f32x4*)(op_ + 4 * MODW) = a4; } while (0)
    constexpr int GV_ROWS = 32, P2_WIN = 2500;
    constexpr int GV_P0 = KS_MOD * 24, GV_P3 = KS_MOD * 48;
    constexpr int GV_L = KS_MOD * 72, GV_P2 = GV_L / 2;

    if (IN(0)) REP(0) {
#define A3_BLOCK() \
        { \
            LAS float* WL = (LAS float*)F.lds; \
            for (int i = F.tid; i < 33 * 64; i += NTHR) WL[i] = args.in[I_FW1][i]; \
            for (int i = F.tid; i < 64 * 64; i += NTHR) { WL[2112 + i] = args.in[I_FW2][i]; WL[2112 + 4096 + i] = args.in[I_FW3][i]; } \
            __syncthreads(); \
            const int l = F.lane; \
            const float b1 = args.in[I_FB1][l], b2 = args.in[I_FB2][l], b3 = args.in[I_FB3][l], f1 = args.in[I_FREQ][l], f2 = args.in[I_FREQ][64 + l], f3 = args.in[I_FREQ][128 + l]; \
            for (int t = F.gw; t < SEQ; t += F.NGW) { \
                float z = 0.f; \
                { const float w = 6.283185307179586f * (float)t / 4096.0f; \
                  if (l == 0) z = (float)t / 4095.0f; \
                  else if (l <= 16) { const float f = 1e-4f + (float)(l - 1) * ((15.0f - 1e-4f) / 15.0f); z = cosf(f * w); } \
                  else if (l <= 32) { const float f = 1e-4f + (float)(l - 17) * ((15.0f - 1e-4f) / 15.0f); z = -sinf(f * w); } } \
                float s = b1; \
_Pragma("unroll") \
                for (int i = 0; i < 33; ++i) s += __shfl(z, i) * WL[i * 64 + l]; \
                float a = sinf(f1 * s); \
                s = b2; \
_Pragma("unroll 16") \
                for (int i = 0; i < 64; ++i) s += __shfl(a, i) * WL[2112 + i * 64 + l]; \
                a = sinf(f2 * s); \
                s = b3; \
_Pragma("unroll 16") \
                for (int i = 0; i < 64; ++i) s += __shfl(a, i) * WL[2112 + 4096 + i * 64 + l]; \
                a = sinf(f3 * s); \
                A3[t * 64 + l] = a; \
            } \
            __syncthreads(); \
        }
        const bool a3_first = (blockIdx.x & 1) == 0;
        if (a3_first) A3_BLOCK()
        BUILD_SC();
        const int pw = F.wave * F.G + (int)blockIdx.x;
        if (F.NGW > GV_L) { if (pw < GV_P0) GEMV_ITEM(0, (pw / 24) * 72 + pw % 24); } else for (int it_ = pw; it_ < GV_P0; it_ += F.NGW) GEMV_ITEM(0, (it_ / 24) * 72 + it_ % 24);
        for (int i = blockIdx.x * NTHR + F.tid; i < SEQ * 64; i += F.G * NTHR) {
            const int t = i >> 6, j = i & 63; const float pos = (float)(j < 32 ? (t >> 6) : (t & 63));
            const float inv = powf(10000.0f, -(float)(j & 31) / 32.0f); const float ang = pos * inv;
            rotc[i] = cosf(ang); rots[i] = sinf(ang);
        }
        if (F.NGW > GV_L) { if (pw >= GV_P0) for (int it_ = pw - GV_P0; it_ < CV_P0UP; it_ += F.NGW - GV_P0) CONVERT_ITEM(it_); }
        else for (int it_ = pw; it_ < CV_P0UP; it_ += F.NGW) CONVERT_ITEM(it_);
        if (!a3_first) { __syncthreads(); A3_BLOCK() }
        __syncthreads();
    }
    SEAM(0);

    if (IN(1)) REP(1) {
        for (int i = blockIdx.x * NTHR + F.tid; i < 5 * MODW / 4; i += F.G * NTHR) {
            const int e = i * 4, layer = e / (5 * MODW), r = (e / MODW) % 5, col = e % MODW;
            if (col < 3 * DM) *(f32x4*)(mod + e) = mod_from_partials(modp, args.in[I_BMOD], layer, r, col);
        }
        norm_pass(F, args.in[I_X], args.in[I_CTX], MA, nullptr, modp, args.in[I_BMOD], 0, 0, HN, F8_UP);
    }
    SEAM(1);

#define FFN_UP(f, MROWS) do { constexpr int KE = F8_UP ? DM / 2 : DM; pg8::Gemm g{KE, KE, KE}; pg8::StaticOrder S; S.init(HN, Wup + (size_t)(f) * UPSZ, (MROWS), NUP, KE, KE, F.G, (int)blockIdx.x); \
        pg8::EpiSwiglu<F8_DN != 0> E{HID, F8_DN ? DFF : DFF, F8_UP ? 1.0f / (pg8::F8S_ACT * pg8::F8S_WUP) : 1.0f}; pg8::gemm_phase<pg8::EpiSwiglu<F8_DN != 0>, pg8::StaticOrder, true, true, F8_UP != 0>(F.lds, g, S, E); } while (0)
#define FFN_DN(f, MROWS, BF32_, BL, BC, LAYER, J) do { constexpr int KE = F8_DN ? DFF / 2 : DFF; pg8::Gemm g{KE, KE, KE}; pg8::StaticOrder S; S.init(HID, Wdn + (size_t)(f) * DNSZ, (MROWS), DM, KE, KE, F.G, (int)blockIdx.x); \
        pg8::EpiResid<BF32_> E{(BL), (BC), (pg8::bf16_t*)XB, mod + ((size_t)((LAYER) * 5) * 9 + (J)) * DM, 9 * DM, nullptr, F8_DN ? 0.5f / (pg8::F8S_HID * pg8::F8S_WDN) : 0.5f}; pg8::gemm_phase<pg8::EpiResid<BF32_>, pg8::StaticOrder, true, true, F8_DN != 0>(F.lds, g, S, E); } while (0)

    if (IN(2)) REP(2) { FFN_UP(0, MA);
        const int nun_ = (MA / 256) * (NUP / 256), fi_ = nun_ % F.G, nidle_ = fi_ ? F.G - fi_ : F.G, widx_ = fi_ ? (int)blockIdx.x - fi_ : (int)blockIdx.x;
        if (widx_ >= 0) { BUILD_SC(); for (int it_ = F.wave * nidle_ + widx_; it_ < GV_P2; it_ += nidle_ * NWAVES) GEMV_ITEM(1, it_);
            for (int it_ = F.wave * nidle_ + widx_; it_ < NI_DN; it_ += nidle_ * NWAVES) CONVERT_ITEM(CV_P0UP + it_);
            for (int it_ = F.wave * nidle_ + widx_; it_ < P2_WIN; it_ += nidle_ * NWAVES) CONVERT_ITEM(CV_N0 + it_);
            __syncthreads(); }
    }
    SEAM(2);
    if (IN(3)) { FFN_DN(0, MA, true, args.in[I_X], args.in[I_CTX], 0, 2);
        LAS float* W4T = (LAS float*)F.lds;
        for (int it = (int)blockIdx.x - 32; it >= 0 && it < 512; it += F.G - 32) {
            const int tb = it >> 6, cb = it & 63, t = tb * 512 + F.tid;
            __syncthreads();
            for (int i = F.tid; i < 4096; i += NTHR) { const int k = i >> 6, c = i & 63; W4T[c * 64 + k] = args.in[I_FW4][(size_t)k * 4096 + cb * 64 + c]; }
            typedef float f32x2_ __attribute__((ext_vector_type(2)));
            f32x2_ a2[32];
#pragma unroll
            for (int q = 0; q < 16; ++q) { const f32x4 v = *(const f32x4*)(A3 + (size_t)t * 64 + 4 * q); a2[2 * q] = (f32x2_){v.x, v.y}; a2[2 * q + 1] = (f32x2_){v.z, v.w}; }
            __syncthreads();
            const float tn = (float)t / 4095.0f;
#pragma unroll 2
            for (int c = 0; c < 64; ++c) {
                f32x2_ sa = {0.f, 0.f}, sb = {0.f, 0.f};
#pragma unroll
                for (int q = 0; q < 16; ++q) { const f32x4 w = *(const LAS f32x4*)(W4T + c * 64 + 4 * q); sa += a2[2 * q] * (f32x2_){w.x, w.y}; sb += a2[2 * q + 1] * (f32x2_){w.z, w.w}; }
                const float s = (sa.x + sa.y) + (sb.x + sb.y);
                const int col = cb * 64 + c, o = col >> 11, side = (col >> 10) & 1, ch = col & 1023;
                const float mind = -3.0701134573253945f, maxd = -15.350567286626973f;
                const float delta = fabsf(mind + (float)ch * ((maxd - mind) / 1023.0f));
                const float val = s * expf(-tn * delta);
                bf16* kr = KR + ((size_t)(o * 1024 + ch)) * 8192;
                if (side == 0) kr[4096 - t] = (bf16)f2bf(val);
                else kr[t == 0 ? 0 : 4096 + t] = (bf16)f2bf(t == 0 ? 0.0f : val);
            }
        }
        __syncthreads();
        if (blockIdx.x >= 32) { constexpr int LO_ = CV_N0 + P2_WIN, N_ = CV_N1A - P2_WIN;
            const int nw_ = F.G - 32, wgi_ = (int)blockIdx.x - 32, krx_ = nw_ < 512 ? 512 % nw_ : 0, nb_ = (nw_ - krx_) * NWAVES;
            BUILD_SC();
            const int ngv_ = nb_ >= GV_P3 ? GV_P3 : 0, nb2_ = nb_ - ngv_;
            int pre_ = 3 * nb2_; if (pre_ > N_) pre_ = 0;
            constexpr int GV_ROWS = 16;
            if (wgi_ >= krx_) { const int wb_ = (wgi_ - krx_) + (nw_ - krx_) * F.wave;
                if (wb_ < ngv_) GEMV_ITEM(0, (wb_ / 48) * 72 + 24 + wb_ % 48);
                else if (pre_ > 0) { for (int j_ = 0; j_ < 3; ++j_) CONVERT_ITEM(LO_ + (wb_ - ngv_) + j_ * nb2_); } }
            if (ngv_ == 0) for (int it_ = wgi_ + nw_ * F.wave; it_ < GV_P3; it_ += nw_ * NWAVES) GEMV_ITEM(0, (it_ / 48) * 72 + 24 + it_ % 48);
            for (int it_ = pre_ + wgi_ + nw_ * F.wave; it_ < N_; it_ += nw_ * NWAVES) CONVERT_ITEM(LO_ + it_); }
        __syncthreads();
    }
    SEAM(3);
    if (IN(4)) REP(4) {
        int i0_ = blockIdx.x * NTHR + F.tid; asm volatile("" : "+v"(i0_));
        for (int i = i0_; i < 5 * MODW / 4; i += F.G * NTHR) {
            const int e = i * 4, r = e / MODW, col = e % MODW;
            if (col >= 3 * DM) *(f32x4*)(mod + e) = mod_from_partials(modp, args.in[I_BMOD], 0, r, col);
        }
        norm_pass_h(F, XB, MA, mod, 0, 3, HN, false, modp, args.in[I_BMOD]);
    }
    SEAM(4);
    if (IN(5)) REP(5) {
        struct WinOrder {
            int G, c; const char* HN; const char* Win;
            __device__ __forceinline__ bool next(int i, pg8::Unit& u) const {
                const int L = i * G + c; const size_t ps = (size_t)256 * DM * 2;
                if (L < 1024) { pg8::tile_of(L, 64, 16, u.pm, u.pn); u.A = HN + u.pm * ps; u.B = Win + u.pn * ps; u.ty = u.pn < 4 ? 0 : (u.pn < 8 ? 1 : (u.pn < 12 ? 2 : 3)); return true; }
                if (L < 1792) { pg8::tile_of(L - 1024, 12, 64, u.pm, u.pn); u.A = Win + (size_t)(16 + u.pm) * ps; u.B = HN + u.pn * ps; u.ty = 4; return true; }
                if (L < 1824) { pg8::tile_of(L - 1792, 4, 8, u.pm, u.pn); u.A = HN + (size_t)(64 + u.pm) * ps; u.B = Win + (size_t)(4 + u.pn) * ps; u.ty = 5; return true; }
                return false;
            }
        } S{F.G, (int)blockIdx.x, (const char*)HN, (const char*)Win};
        pg8::Gemm g{DM, DM, DM};
        pg8::EpiWin E{ws, rotc, rots};
        pg8::gemm_phase<pg8::EpiWin, WinOrder, true, true>(F.lds, g, S, E);
        if (blockIdx.x >= 32) { BUILD_SC();
            const int nwg_ = F.G - 32, wk_ = F.wave * nwg_ + ((int)blockIdx.x - 32), nwk_ = nwg_ * NWAVES, ng_ = GV_L - GV_P2;
            constexpr int NV_ = NI_WOUT + CV_N1B;
#define P5_ITEM(V) do { const int v_ = (V); if (v_ < NI_WOUT) CONVERT_ITEM(CV_P0 + v_); else CONVERT_ITEM(CV_N0 + CV_N1A + (v_ - NI_WOUT)); } while (0)
            if (nwk_ > ng_) { const int pre_ = 8 * (nwk_ - ng_);
                if (wk_ < ng_) GEMV_ITEM(1, GV_P2 + wk_); else for (int j_ = 0; j_ < 8; ++j_) P5_ITEM((wk_ - ng_) + j_ * (nwk_ - ng_));
                for (int it_ = pre_ + wk_; it_ < NV_; it_ += nwk_) P5_ITEM(it_); }
            else { for (int it_ = wk_; it_ < ng_; it_ += nwk_) GEMV_ITEM(1, GV_P2 + it_); for (int it_ = wk_; it_ < NV_; it_ += nwk_) P5_ITEM(it_); }
#undef P5_ITEM
        }
        __syncthreads();
    }
    SEAM(5);

    if (IN(6)) REP(6) {
        for (int un0 = blockIdx.x; un0 < 256; un0 += F.G) {
            const int un = (F.G == 256) ? (((un0 & 7) * 4 + (un0 >> 6)) * 8 + ((un0 >> 3) & 7)) : un0;
            const int bh = un >> 3, dir = (un >> 2) & 1, es = un & 3, b = bh >> 3, h = bh & 7;
            const float lg = args.in[I_LOGD][dir * 8 + h];
            const float cdec = fexp(128.0f * lg);
            constexpr int SC_K = 128 * 272, SC_V = 128 * 80, SC_SET = SC_K + SC_V;
            f32x4 acc[2] = {(f32x4){0, 0, 0, 0}, (f32x4){0, 0, 0, 0}};
            const int g4 = F.lane >> 4, q4 = (F.lane & 15) >> 2, p4 = F.lane & 3;
            v4u kraw[2][4], vraw[2];
#define SCAN_PTRS(step_) int cidx; bool isctx; if (dir == 0) { isctx = (step_) < 2; cidx = isctx ? (step_) : (step_) - 2; } else { isctx = (step_) < 2; cidx = isctx ? 1 - (step_) : 33 - (step_); } \
                const bf16* kp; const bf16* vp; int ld; if (isctx) { kp = KVC + (size_t)(b * CTXL + cidx * 128) * 2048 + h * 128; vp = kp + 1024; ld = 2048; } else { kp = QKVG + (size_t)(b * SEQ + cidx * 128) * 4096 + 1024 + h * 128; vp = kp + 1024; ld = 4096; }
#define SCAN_FETCH(S_) do { _Pragma("unroll") for (int i = 0; i < 4; ++i) { const int id = F.tid + NTHR * i, j = id >> 4, c8 = id & 15; kraw[S_][i] = *(const GAS v4u*)(kp + (size_t)j * ld + c8 * 8); } \
                { const int j = F.tid >> 2, c8 = F.tid & 3; vraw[S_] = *(const GAS v4u*)(vp + (size_t)j * ld + es * 32 + c8 * 8); } } while (0)
            { SCAN_PTRS(0); SCAN_FETCH(0); } { SCAN_PTRS(1); SCAN_FETCH(1); }
            for (int it = 0; it < 17; ++it) {
                LDS_BARRIER();
#pragma unroll
                for (int S_ = 0; S_ < 2; ++S_) {
#pragma unroll
                    for (int i = 0; i < 4; ++i) { const int id = F.tid + NTHR * i, j = id >> 4, c8 = id & 15; const v4u raw = kraw[S_][i];
                        const float kd = fexp(lg * (float)(dir == 0 ? 127 - j : j));
                        v4u o; o.x = pk2(bflo(raw.x) * kd, bfhi(raw.x) * kd); o.y = pk2(bflo(raw.y) * kd, bfhi(raw.y) * kd); o.z = pk2(bflo(raw.z) * kd, bfhi(raw.z) * kd); o.w = pk2(bflo(raw.w) * kd, bfhi(raw.w) * kd);
                        *(LAS v4u*)(F.lds + S_ * SC_SET + j * 272 + c8 * 16) = o; }
                    { const int j = F.tid >> 2, c8 = F.tid & 3; *(LAS v4u*)(F.lds + S_ * SC_SET + SC_K + j * 80 + c8 * 16) = vraw[S_]; } }
                if (it + 1 < 17) { { SCAN_PTRS(2 * it + 2); SCAN_FETCH(0); } { SCAN_PTRS(2 * it + 3); SCAN_FETCH(1); } }
                LDS_BARRIER();
                f32x4 u[2][2];
#pragma unroll
                for (int S_ = 0; S_ < 2; ++S_) { u[S_][0] = (f32x4){0, 0, 0, 0}; u[S_][1] = (f32x4){0, 0, 0, 0};
                    LAS unsigned char* KL = F.lds + S_ * SC_SET; LAS unsigned char* VL = KL + SC_K;
#pragma unroll
                    for (int ks = 0; ks < 4; ++ks) {
                        const s16x4 a0 = __builtin_amdgcn_ds_read_tr16_b64_v4i16((LAS s16x4*)(KL + (32 * ks + 8 * g4 + q4) * 272 + (16 * F.wave + 4 * p4) * 2));
                        const s16x4 a1 = __builtin_amdgcn_ds_read_tr16_b64_v4i16((LAS s16x4*)(KL + (32 * ks + 8 * g4 + 4 + q4) * 272 + (16 * F.wave + 4 * p4) * 2));
                        bf16x8 af; af[0] = a0[0]; af[1] = a0[1]; af[2] = a0[2]; af[3] = a0[3]; af[4] = a1[0]; af[5] = a1[1]; af[6] = a1[2]; af[7] = a1[3];
#pragma unroll
                        for (int c = 0; c < 2; ++c) {
                            const s16x4 b0 = __builtin_amdgcn_ds_read_tr16_b64_v4i16((LAS s16x4*)(VL + (32 * ks + 8 * g4 + q4) * 80 + (16 * c + 4 * p4) * 2));
                            const s16x4 b1 = __builtin_amdgcn_ds_read_tr16_b64_v4i16((LAS s16x4*)(VL + (32 * ks + 8 * g4 + 4 + q4) * 80 + (16 * c + 4 * p4) * 2));
                            bf16x8 bfr; bfr[0] = b0[0]; bfr[1] = b0[1]; bfr[2] = b0[2]; bfr[3] = b0[3]; bfr[4] = b1[0]; bfr[5] = b1[1]; bfr[6] = b1[2]; bfr[7] = b1[3];
                            u[S_][c] = __builtin_amdgcn_mfma_f32_16x16x32_bf16(af, bfr, u[S_][c], 0, 0, 0);
                        }
                    } }
#pragma unroll
                for (int S_ = 0; S_ < 2; ++S_) {
                    SCAN_PTRS(2 * it + S_);
                    if (!isctx) {
                        bf16* sp = SPREV + ((size_t)((bh * 2 + dir) * 32 + cidx)) * 16384;
#pragma unroll
                        for (int c = 0; c < 2; ++c)
#pragma unroll
                            for (int r = 0; r < 4; ++r) sp[(size_t)(16 * F.wave + 4 * g4 + r) * 128 + es * 32 + 16 * c + (F.lane & 15)] = (bf16)f2bf(acc[c][r]);
                    }
                    acc[0] = acc[0] * cdec + u[S_][0]; acc[1] = acc[1] * cdec + u[S_][1];
                }
            }
            LDS_BARRIER();
        }
#undef SCAN_PTRS
#undef SCAN_FETCH
#if HY_NAIVE
        for (int ch = blockIdx.x; ch < 1024; ch += F.G) {
            LAS float* Kf = (LAS float*)F.lds;
            LAS float* U = (LAS float*)(F.lds + 32768);
            const float* cw = args.in[I_CONVW]; const float* cb = args.in[I_CONVB];
            float acc[8][4];
            for (int cv = 0; cv < 2; ++cv) {
                __syncthreads();
                for (int i = F.tid; i < 8192; i += NTHR) Kf[i] = bf2f(KR[((size_t)(cv * 1024 + ch)) * 8192 + i]);
                if (cv == 0) {
                    const float w0 = cw[ch], w1 = cw[3072 + ch], w2 = cw[6144 + ch], bb = cb[ch];
                    for (int i = F.tid; i < 16384; i += NTHR) { const int b = i >> 12, t = i & 4095; const bf16* p = PHT + (size_t)ch * 16384 + i;
                        const float pm = t > 0 ? bf2f(p[-1]) : 0.f, p0 = bf2f(p[0]), pp = t < 4095 ? bf2f(p[1]) : 0.f;
                        U[t * 4 + b] = bb + pm * w0 + p0 * w1 + pp * w2; }
                } else {
                    const int c1 = 1024 + ch; const float w0 = cw[c1], w1 = cw[3072 + c1], w2 = cw[6144 + c1], bb = cb[c1], hb = args.in[I_HYB][ch];
#pragma unroll
                    for (int i = 0; i < 8; ++i)
#pragma unroll
                        for (int b = 0; b < 4; ++b) { const int t = F.tid + NTHR * i; const bf16* p = PHT + (size_t)c1 * 16384 + b * 4096 + t;
                            const float pm = t > 0 ? bf2f(p[-1]) : 0.f, p0 = bf2f(p[0]), pp = t < 4095 ? bf2f(p[1]) : 0.f;
                            const float x1 = bb + pm * w0 + p0 * w1 + pp * w2;
                            acc[i][b] = x1 * (acc[i][b] + hb * U[t * 4 + b]); }
                    __syncthreads();
#pragma unroll
                    for (int i = 0; i < 8; ++i)
#pragma unroll
                        for (int b = 0; b < 4; ++b) U[(F.tid + NTHR * i) * 4 + b] = acc[i][b];
                }
                __syncthreads();
                float a[8][4];
#pragma unroll
                for (int i = 0; i < 8; ++i)
#pragma unroll
                    for (int b = 0; b < 4; ++b) a[i][b] = 0.f;
                for (int s = 0; s < 4096; ++s) {
                    const f32x4 u = *(const LAS f32x4*)(U + s * 4);
#pragma unroll
                    for (int i = 0; i < 8; ++i) { const float kv = Kf[4096 - (F.tid + NTHR * i) + s]; a[i][0] += kv * u.x; a[i][1] += kv * u.y; a[i][2] += kv * u.z; a[i][3] += kv * u.w; }
                }
#pragma unroll
                for (int i = 0; i < 8; ++i)
#pragma unroll
                    for (int b = 0; b < 4; ++b) acc[i][b] = a[i][b];
            }
            { const int c2 = 2048 + ch; const float w0 = cw[c2], w1 = cw[3072 + c2], w2 = cw[6144 + c2], bb = cb[c2], hb = args.in[I_HYB][1024 + ch];
#pragma unroll
              for (int i = 0; i < 8; ++i)
#pragma unroll
                  for (int b = 0; b < 4; ++b) { const int t = F.tid + NTHR * i; const bf16* p = PHT + (size_t)c2 * 16384 + b * 4096 + t;
                      const float pm = t > 0 ? bf2f(p[-1]) : 0.f, p0 = bf2f(p[0]), pp = t < 4095 ? bf2f(p[1]) : 0.f;
                      const float x2 = bb + pm * w0 + p0 * w1 + pp * w2;
                      YHT[(size_t)ch * 16384 + b * 4096 + t] = (bf16)f2bf(x2 * (acc[i][b] + hb * U[t * 4 + b])); } }
            __syncthreads();
        }
#else
        {
            constexpr int HY_CP = 16448, HY_U = 4 * HY_CP, HY_UB = 4608 * 2, HY_X = HY_U + 4 * HY_UB;
            const float* cw = args.in[I_CONVW]; const float* cb = args.in[I_CONVB];
            const int l15 = F.lane & 15, g4 = F.lane >> 4, tau0 = 2 * F.wave;
            const int sg = (-l15) & 3, ci4 = (l15 + 3) >> 2;
            const int mlo = -(8 * tau0 + 8);
            const unsigned a_base = (unsigned)(sg * HY_CP + 2 * (4096 + 16 + 32 * mlo + 8 * g4 - 4 * ci4));
            const unsigned b_base = (unsigned)(HY_U + 2 * (256 + 256 * tau0 + 16 * l15 + 32 * mlo + 8 * g4));
            v4u tp[3]; v4u ra[4], rb[4]; unsigned ral[4], rar[4], rbl[4], rbr[4]; float wa[4], wb[4], hb0 = 0.f, hb1 = 0.f;
#define HY_PF_TAPS(KRP) do { _Pragma("unroll") for (int i_ = 0; i_ < 3; ++i_) { const int c_ = F.tid + NTHR * i_, x0_ = 8 * c_ - 16; tp[i_] = (v4u){0u, 0u, 0u, 0u}; \
                if (c_ < 1028 && x0_ >= 0 && x0_ < 8192) tp[i_] = *(const GAS v4u*)((KRP) + x0_); } } while (0)
#define HY_WR_TAPS() do { _Pragma("unroll") for (int i_ = 0; i_ < 3; ++i_) { const int c_ = F.tid + NTHR * i_; if (c_ < 1028) *(LAS v4u*)(F.lds + c_ * 16) = tp[i_]; } } while (0)
#define HY_PF_ROW(R_, RL_, RR_, W_, CC) do { const unsigned short* prow_ = (const unsigned short*)(PHT + (size_t)(CC) * 16384); W_[0] = cw[(CC)]; W_[1] = cw[3072 + (CC)]; W_[2] = cw[6144 + (CC)]; W_[3] = cb[(CC)]; \
                _Pragma("unroll") for (int it = 0; it < 4; ++it) { const int id = F.tid + NTHR * it, b = id >> 9, t0 = (id & 511) * 8; const unsigned short* p = prow_ + b * 4096 + t0; \
                    R_[it] = *(const GAS v4u*)p; RL_[it] = t0 > 0 ? (unsigned)p[-1] : 0u; RR_[it] = t0 < 4088 ? (unsigned)p[8] : 0u; } } while (0)
#define HY_WR_ROW(R_, RL_, RR_, W_, TO_U) do { const float w0 = W_[0], w1 = W_[1], w2 = W_[2], bb = W_[3]; \
                _Pragma("unroll") for (int it = 0; it < 4; ++it) { const int id = F.tid + NTHR * it, b = id >> 9, t0 = (id & 511) * 8; const v4u raw = R_[it]; \
                    const float x[10] = {bf2f((unsigned short)RL_[it]), bflo(raw.x), bfhi(raw.x), bflo(raw.y), bfhi(raw.y), bflo(raw.z), bfhi(raw.z), bflo(raw.w), bfhi(raw.w), bf2f((unsigned short)RR_[it])}; \
                    float o[8]; _Pragma("unroll") for (int e = 0; e < 8; ++e) o[e] = bb + x[e] * w0 + x[e + 1] * w1 + x[e + 2] * w2; \
                    v4u ov; ov.x = pk2(o[0], o[1]); ov.y = pk2(o[2], o[3]); ov.z = pk2(o[4], o[5]); ov.w = pk2(o[6], o[7]); \
                    if (TO_U) *(LAS v4u*)(F.lds + HY_U + b * HY_UB + (256 + t0) * 2) = ov; else *(LAS v4u*)(F.lds + HY_X + (b * 4096 + t0) * 2) = ov; } } while (0)
#define HY_COPIES() do { for (int w = F.tid; w < 2056; w += NTHR) { \
                const unsigned long long lo = *(const LAS unsigned long long*)(F.lds + w * 8), hi = (w < 2055) ? *(const LAS unsigned long long*)(F.lds + w * 8 + 8) : 0ull; \
                _Pragma("unroll") for (int sgm = 1; sgm < 4; ++sgm) *(LAS unsigned long long*)(F.lds + sgm * HY_CP + w * 8) = (lo >> (16 * sgm)) | (hi << (64 - 16 * sgm)); } } while (0)
#define HY_EPI(CV, CH, HB) do { const float hb = (HB); \
                _Pragma("unroll") for (int j = 0; j < 2; ++j) _Pragma("unroll") for (int b = 0; b < 4; ++b) { \
                    const int t = 256 * (tau0 + j) + 16 * l15 + 4 * g4; \
                    const v2u uv = *(const LAS v2u*)(F.lds + HY_U + b * HY_UB + (256 + t) * 2), xv = *(const LAS v2u*)(F.lds + HY_X + (b * 4096 + t) * 2); \
                    const float o0 = bflo(xv.x) * (acc[j][b][0] + hb * bflo(uv.x)), o1 = bfhi(xv.x) * (acc[j][b][1] + hb * bfhi(uv.x)); \
                    const float o2 = bflo(xv.y) * (acc[j][b][2] + hb * bflo(uv.y)), o3 = bfhi(xv.y) * (acc[j][b][3] + hb * bfhi(uv.y)); \
                    v2u ov; ov.x = pk2(o0, o1); ov.y = pk2(o2, o3); \
                    if ((CV) == 0) *(LAS v2u*)(F.lds + HY_U + b * HY_UB + (256 + t) * 2) = ov; \
                    else *(GAS v2u*)(YHT + (size_t)(CH) * 16384 + b * 4096 + t) = ov; } } while (0)
#define HY_LOAD(A0_, A1_, B_, aa_, ba_) do { const s16x4 a00_ = *(const volatile LAS s16x4*)(F.lds + (aa_)), a01_ = *(const volatile LAS s16x4*)(F.lds + (aa_) + 8), a10_ = *(const volatile LAS s16x4*)(F.lds + (aa_) - 512), a11_ = *(const volatile LAS s16x4*)(F.lds + (aa_) - 504);     \
                A0_ = __builtin_shufflevector(a00_, a01_, 0, 1, 2, 3, 4, 5, 6, 7); A1_ = __builtin_shufflevector(a10_, a11_, 0, 1, 2, 3, 4, 5, 6, 7); \
                _Pragma("unroll") for (int b = 0; b < 4; ++b) B_[b] = *(const LAS bf16x8*)(F.lds + (ba_) + b * HY_UB); } while (0)
#define HY_MMA(A0_, A1_, B_) do { _Pragma("unroll") for (int b = 0; b < 4; ++b) { acc[0][b] = __builtin_amdgcn_mfma_f32_16x16x32_bf16(A0_, B_[b], acc[0][b], 0, 0, 0); acc[1][b] = __builtin_amdgcn_mfma_f32_16x16x32_bf16(A1_, B_[b], acc[1][b], 0, 0, 0); } } while (0)
#define HY_LOOP() do { _Pragma("unroll") for (int j = 0; j < 2; ++j) _Pragma("unroll") for (int b = 0; b < 4; ++b) acc[j][b] = (f32x4){0.f, 0.f, 0.f, 0.f}; \
                bf16x8 XA0, XA1, XB[4], YA0, YA1, YB[4]; unsigned aa = a_base, ba = b_base; \
                HY_LOAD(XA0, XA1, XB, aa, ba); \
                for (int m = 0; m < 136; m += 2) { \
                    HY_LOAD(YA0, YA1, YB, aa + 64, ba + 64); __builtin_amdgcn_sched_barrier(0); \
                    HY_MMA(XA0, XA1, XB); __builtin_amdgcn_sched_barrier(0); \
                    if (m + 2 < 136) HY_LOAD(XA0, XA1, XB, aa + 128, ba + 128); \
                    __builtin_amdgcn_sched_barrier(0); \
                    HY_MMA(YA0, YA1, YB); __builtin_amdgcn_sched_barrier(0); \
                    aa += 128; ba += 128; } } while (0)
            f32x4 acc[2][4];
            int ch = blockIdx.x, chp = -1;
            if (ch < 1024) { HY_PF_TAPS(KR + (size_t)ch * 8192); HY_PF_ROW(ra, ral, rar, wa, ch); HY_PF_ROW(rb, rbl, rbr, wb, 1024 + ch); }
            for (; ch < 1024; ch += F.G) {
                LDS_BARRIER();
                if (chp >= 0) HY_EPI(1, chp, hb1);
                HY_WR_TAPS();
                LDS_BARRIER();
                if (F.tid < 256) { const int b = F.tid >> 6, q = F.tid & 63; const int off = (q < 32 ? q * 8 : 4352 + (q - 32) * 8); *(LAS v4u*)(F.lds + HY_U + b * HY_UB + off * 2) = (v4u){0u, 0u, 0u, 0u}; }
                HY_WR_ROW(ra, ral, rar, wa, true); HY_WR_ROW(rb, rbl, rbr, wb, false);
                HY_COPIES();
                hb0 = args.in[I_HYB][ch]; HY_PF_TAPS(KR + (size_t)(1024 + ch) * 8192); HY_PF_ROW(ra, ral, rar, wa, 2048 + ch);
                LDS_BARRIER();
                HY_LOOP();
                LDS_BARRIER();
                HY_EPI(0, ch, hb0);
                HY_WR_TAPS();
                LDS_BARRIER();
                HY_WR_ROW(ra, ral, rar, wa, false);
                HY_COPIES();
                hb1 = args.in[I_HYB][1024 + ch];
                if (ch + F.G < 1024) { const int chn = ch + F.G; HY_PF_TAPS(KR + (size_t)chn * 8192); HY_PF_ROW(ra, ral, rar, wa, chn); HY_PF_ROW(rb, rbl, rbr, wb, 1024 + chn); }
                LDS_BARRIER();
                HY_LOOP();
                chp = ch;
            }
            LDS_BARRIER();
            if (chp >= 0) HY_EPI(1, chp, hb1);
            LDS_BARRIER();
#undef HY_PF_TAPS
#undef HY_WR_TAPS
#undef HY_PF_ROW
#undef HY_WR_ROW
#undef HY_COPIES
#undef HY_EPI
#undef HY_LOAD
#undef HY_MMA
#undef HY_LOOP
        }
#endif
    }
    SEAM(6);

    if (IN(7)) REP(7) {
        constexpr int PT = 272;
        LAS unsigned char* QL = F.lds; LAS unsigned char* KL = F.lds + 128 * PT; LAS unsigned char* VL = F.lds + 2 * 128 * PT; LAS unsigned char* SL = F.lds + 3 * 128 * PT;
        const int g4 = F.lane >> 4, q4 = (F.lane & 15) >> 2, p4 = F.lane & 3, l15 = F.lane & 15, w = F.wave;
        v4u pq[4], pk[4], pv[4], ps[4], pb[4];
#define RO_FETCH_QK(UN) do { const int bh_ = (UN) >> 5, c_ = (UN) & 31; const bf16* qp_ = QKVG + ((size_t)(bh_ >> 3) * SEQ + c_ * 128) * 4096 + (bh_ & 7) * 128; \
            _Pragma("unroll") for (int i = 0; i < 4; ++i) { const int id = F.tid + NTHR * i, j = id >> 4, c8 = id & 15; \
                pq[i] = *(const GAS v4u*)(qp_ + (size_t)j * 4096 + c8 * 8); pk[i] = *(const GAS v4u*)(qp_ + (size_t)j * 4096 + 1024 + c8 * 8); } } while (0)
        if ((int)blockIdx.x < 1024) RO_FETCH_QK((int)blockIdx.x);
        for (int un = blockIdx.x; un < 1024; un += F.G) {
            const int bh = un >> 5, c = un & 31, b = bh >> 3, h = bh & 7;
            const float lgf = args.in[I_LOGD][h], lgb = args.in[I_LOGD][8 + h];
            const size_t row0 = (size_t)b * SEQ + c * 128;
            const bf16* qp = QKVG + row0 * 4096 + h * 128;
            LDS_BARRIER();
#pragma unroll
            for (int i = 0; i < 4; ++i) { const int id = F.tid + NTHR * i, j = id >> 4, c8 = id & 15; *(LAS v4u*)(QL + j * PT + c8 * 16) = pq[i]; *(LAS v4u*)(KL + j * PT + c8 * 16) = pk[i]; }
#pragma unroll
            for (int i = 0; i < 4; ++i) { const int id = F.tid + NTHR * i, j = id >> 4, c8 = id & 15;
                ps[i] = *(const GAS v4u*)(SPREV + ((size_t)((bh * 2 + 0) * 32 + c)) * 16384 + j * 128 + c8 * 8);
                pv[i] = *(const GAS v4u*)(qp + (size_t)j * 4096 + 2048 + c8 * 8); }
            if (un + F.G < 1024) RO_FETCH_QK(un + F.G);
            LDS_BARRIER();
            bf16x8 qf[4];
#pragma unroll
            for (int ks = 0; ks < 4; ++ks) qf[ks] = *(const LAS bf16x8*)(QL + (16 * w + l15) * PT + (32 * ks + 8 * g4) * 2);
            f32x4 sc[8];
#pragma unroll
            for (int jb = 0; jb < 8; ++jb) { sc[jb] = (f32x4){0, 0, 0, 0};
#pragma unroll
                for (int ks = 0; ks < 4; ++ks) { const bf16x8 kf = *(const LAS bf16x8*)(KL + (16 * jb + l15) * PT + (32 * ks + 8 * g4) * 2); sc[jb] = __builtin_amdgcn_mfma_f32_16x16x32_bf16(qf[ks], kf, sc[jb], 0, 0, 0); } }
#pragma unroll
            for (int i = 0; i < 4; ++i) { const int id = F.tid + NTHR * i, j = id >> 4, c8 = id & 15; *(LAS v4u*)(SL + j * PT + c8 * 16) = ps[i]; *(LAS v4u*)(VL + j * PT + c8 * 16) = pv[i]; }
            LDS_BARRIER();
            { int dbase = 16 * w + 4 * g4 - l15; asm volatile("" : "+v"(dbase));
#pragma unroll
              for (int jb = 0; jb < 8; ++jb)
#pragma unroll
                  for (int r = 0; r < 4; ++r) { const int i = 16 * w + 4 * g4 + r, j = 16 * jb + l15; const int df = dbase + r - 16 * jb;
                      const float dv = df > 0 ? fexp(lgf * (float)df) : (df < 0 ? fexp(lgb * (float)(-df)) : 2.0f);
                      *(LAS unsigned short*)(KL + i * PT + j * 2) = (unsigned short)f2bf(sc[jb][r] * dv); } }
#pragma unroll
            for (int i = 0; i < 4; ++i) { const int id = F.tid + NTHR * i, j = id >> 4, c8 = id & 15; pb[i] = *(const GAS v4u*)(SPREV + ((size_t)((bh * 2 + 1) * 32 + c)) * 16384 + j * 128 + c8 * 8); }
            f32x4 acc[8];
#pragma unroll
            for (int eb = 0; eb < 8; ++eb) { acc[eb] = (f32x4){0, 0, 0, 0};
#pragma unroll
                for (int ks = 0; ks < 4; ++ks) {
                    const s16x4 b0 = __builtin_amdgcn_ds_read_tr16_b64_v4i16((LAS s16x4*)(SL + (32 * ks + 8 * g4 + q4) * PT + (16 * eb + 4 * p4) * 2));
                    const s16x4 b1 = __builtin_amdgcn_ds_read_tr16_b64_v4i16((LAS s16x4*)(SL + (32 * ks + 8 * g4 + 4 + q4) * PT + (16 * eb + 4 * p4) * 2));
                    bf16x8 bfr; bfr[0] = b0[0]; bfr[1] = b0[1]; bfr[2] = b0[2]; bfr[3] = b0[3]; bfr[4] = b1[0]; bfr[5] = b1[1]; bfr[6] = b1[2]; bfr[7] = b1[3];
                    acc[eb] = __builtin_amdgcn_mfma_f32_16x16x32_bf16(qf[ks], bfr, acc[eb], 0, 0, 0); } }
            LDS_BARRIER();
#pragma unroll
            for (int i = 0; i < 4; ++i) { const int id = F.tid + NTHR * i, j = id >> 4, c8 = id & 15; *(LAS v4u*)(SL + j * PT + c8 * 16) = pb[i]; }
            float sfr[4], sbr[4];
#pragma unroll
            for (int r = 0; r < 4; ++r) { const int i = 16 * w + 4 * g4 + r; sfr[r] = fexp(lgf * (float)(i + 1)); sbr[r] = fexp(lgb * (float)(128 - i)); }
#pragma unroll
            for (int eb = 0; eb < 8; ++eb)
#pragma unroll
                for (int r = 0; r < 4; ++r) acc[eb][r] *= sfr[r] / sbr[r];
            LDS_BARRIER();
#pragma unroll
            for (int eb = 0; eb < 8; ++eb)
#pragma unroll
                for (int ks = 0; ks < 4; ++ks) {
                    const s16x4 b0 = __builtin_amdgcn_ds_read_tr16_b64_v4i16((LAS s16x4*)(SL + (32 * ks + 8 * g4 + q4) * PT + (16 * eb + 4 * p4) * 2));
                    const s16x4 b1 = __builtin_amdgcn_ds_read_tr16_b64_v4i16((LAS s16x4*)(SL + (32 * ks + 8 * g4 + 4 + q4) * PT + (16 * eb + 4 * p4) * 2));
                    bf16x8 bfr; bfr[0] = b0[0]; bfr[1] = b0[1]; bfr[2] = b0[2]; bfr[3] = b0[3]; bfr[4] = b1[0]; bfr[5] = b1[1]; bfr[6] = b1[2]; bfr[7] = b1[3];
                    acc[eb] = __builtin_amdgcn_mfma_f32_16x16x32_bf16(qf[ks], bfr, acc[eb], 0, 0, 0); }
#pragma unroll
            for (int eb = 0; eb < 8; ++eb)
#pragma unroll
                for (int r = 0; r < 4; ++r) acc[eb][r] *= sbr[r];
            bf16x8 pf[4];
#pragma unroll
            for (int ks = 0; ks < 4; ++ks) pf[ks] = *(const LAS bf16x8*)(KL + (16 * w + l15) * PT + (32 * ks + 8 * g4) * 2);
#pragma unroll
            for (int eb = 0; eb < 8; ++eb)
#pragma unroll
                for (int ks = 0; ks < 4; ++ks) {
                    const s16x4 b0 = __builtin_amdgcn_ds_read_tr16_b64_v4i16((LAS s16x4*)(VL + (32 * ks + 8 * g4 + q4) * PT + (16 * eb + 4 * p4) * 2));
                    const s16x4 b1 = __builtin_amdgcn_ds_read_tr16_b64_v4i16((LAS s16x4*)(VL + (32 * ks + 8 * g4 + 4 + q4) * PT + (16 * eb + 4 * p4) * 2));
                    bf16x8 bfr; bfr[0] = b0[0]; bfr[1] = b0[1]; bfr[2] = b0[2]; bfr[3] = b0[3]; bfr[4] = b1[0]; bfr[5] = b1[1]; bfr[6] = b1[2]; bfr[7] = b1[3];
                    acc[eb] = __builtin_amdgcn_mfma_f32_16x16x32_bf16(pf[ks], bfr, acc[eb], 0, 0, 0); }
#pragma unroll
            for (int r = 0; r < 4; ++r) {
                float s2 = 0.f;
#pragma unroll
                for (int eb = 0; eb < 8; ++eb) s2 += acc[eb][r] * acc[eb][r];
                s2 += __shfl_xor(s2, 1); s2 += __shfl_xor(s2, 2); s2 += __shfl_xor(s2, 4); s2 += __shfl_xor(s2, 8);
                const float rstd = 1.0f / sqrtf(s2 * (1.0f / 128.0f) + 1e-6f);
                const size_t row = row0 + 16 * w + 4 * g4 + r;
#pragma unroll
                for (int eb = 0; eb < 8; ++eb) { const int e = 16 * eb + l15; const float gv = bf2f(QKVG[row * 4096 + 3072 + h * 128 + e]);
                    A2[row * DM + h * 128 + e] = (bf16)f2bf(acc[eb][r] * rstd * gv); }
            }
        }
#undef RO_FETCH_QK
        __syncthreads();
        constexpr int TSZ = 64 * 72;
        LAS unsigned short* T = (LAS unsigned short*)F.lds;
        for (int it0 = blockIdx.x; it0 < 16 * 256; it0 += 8 * F.G) {
            v4u raw[8];
#pragma unroll
            for (int i = 0; i < 8; ++i) { const int it = it0 + i * F.G; if (it < 16 * 256) { const int cb = it >> 8, tb = it & 255, chl = F.tid >> 3, tk = F.tid & 7;
                raw[i] = *(const GAS v4u*)(YHT + (size_t)(cb * 64 + chl) * 16384 + tb * 64 + tk * 8); } }
            __syncthreads();
#pragma unroll
            for (int i = 0; i < 8; ++i) { const int it = it0 + i * F.G; if (it < 16 * 256) { const int chl = F.tid >> 3, tk = F.tid & 7; LAS unsigned short* Ti = T + i * TSZ;
                const unsigned wv[4] = {raw[i].x, raw[i].y, raw[i].z, raw[i].w};
#pragma unroll
                for (int x = 0; x < 4; ++x) { Ti[(tk * 8 + 2 * x) * 72 + chl] = (unsigned short)(wv[x] & 0xffffu); Ti[(tk * 8 + 2 * x + 1) * 72 + chl] = (unsigned short)(wv[x] >> 16); } } }
            __syncthreads();
#pragma unroll
            for (int i = 0; i < 8; ++i) { const int it = it0 + i * F.G; if (it < 16 * 256) { const int cb = it >> 8, tb = it & 255, tk = F.tid >> 3, ck = F.tid & 7;
                *(GAS v4u*)(A2 + (size_t)(tb * 64 + tk) * DM + 1024 + cb * 64 + ck * 8) = *(const LAS v4u*)(T + i * TSZ + tk * 72 + ck * 8); } }
        }
        __syncthreads();
    }
    SEAM(7);
    if (IN(8)) { pg8::Gemm g{DM, DM, DM}; pg8::StaticOrder S; S.init(A2, Wout, ML, DM, DM, DM, F.G, (int)blockIdx.x);
        pg8::EpiResid<false> E{XB, XB, (pg8::bf16_t*)XB, mod + ((size_t)(0 * 5) * 9 + 5) * DM, 9 * DM, nullptr, 1.0f}; pg8::gemm_phase<pg8::EpiResid<false>, pg8::StaticOrder, true, true>(F.lds, g, S, E); }
    SEAM(8);
    if (IN(9)) {
        for (int i = blockIdx.x * NTHR + F.tid; i < 5 * MODW / 4; i += F.G * NTHR) {
            const int e = i * 4, r = e / MODW, col = e % MODW;
            *(f32x4*)(mod + 5 * MODW + e) = mod_from_partials(modp, args.in[I_BMOD], 1, r, col);
        }
        norm_pass_h(F, XB, ML, mod, 0, 6, HN, F8_UP);
    }
    SEAM(9);
    if (IN(10)) REP(10) FFN_UP(1, ML);
    SEAM(10);
    if (IN(11)) FFN_DN(1, ML, false, XB, XB, 0, 8);
    SEAM(11);
    if (IN(12)) norm_pass_h(F, XB, ML, mod, 1, 0, HN, F8_UP);
    SEAM(12);
    if (IN(13)) FFN_UP(2, ML);
    SEAM(13);
    if (IN(14)) FFN_DN(2, ML, false, XB, XB, 1, 2);
    SEAM(14);
    if (IN(15)) norm_pass_h(F, XB, ML, mod, 1, 3, HN, false);
    SEAM(15);
    if (IN(16)) REP(16) {
        constexpr int PR = 2080;
        for (int un0 = blockIdx.x; un0 < 512; un0 += F.G) {
            int un = un0;
            if (F.G == 256) { const int w = un0 & 255, r = un0 >> 8, x = w & 7, y = w >> 3, j = x + 8 * (y >> 2); un = (2 * r + (j >> 5)) * 128 + 4 * (j & 31) + (y & 3); }
            const int b = un >> 7, cb = un & 127, hw = 1 << (cb >> 5);
            const bf16* src = HN + (size_t)b * SEQ * DM + cb * 16;
            bf16* dst = DD + (size_t)b * SEQ * DM + cb * 16;
            v4u h[16];
#pragma unroll
            for (int j = 0; j < 16; ++j) { const int idx = F.tid + NTHR * j, token = idx >> 1, half = idx & 1; h[j] = *(const GAS v4u*)(src + (size_t)token * DM + half * 8); }
            __syncthreads();
#pragma unroll
            for (int j = 0; j < 16; ++j) { const int idx = F.tid + NTHR * j, token = idx >> 1, half = idx & 1; *(LAS v4u*)(F.lds + (token >> 6) * PR + (token & 63) * 32 + half * 16) = h[j]; }
            __syncthreads();
#pragma unroll 1
            for (int pass = 0; pass < 2; ++pass) {
                const int line = F.tid >> 3, cp = F.tid & 7;
                const int base = (pass == 0 ? line * PR : line * 32) + cp * 4, stride = pass == 0 ? 32 : PR;
                int hwv = hw; asm volatile("" : "+s"(hwv));
                float s0 = 0.f, s1 = 0.f;
                for (int q = 0; q < hw; ++q) { const unsigned w = *(const LAS unsigned*)(F.lds + base + q * stride); s0 += bflo(w); s1 += bfhi(w); }
                unsigned o[64];
#pragma unroll
                for (int p = 0; p < 64; ++p) {
                    const int lo_ = p - hwv < 0 ? 0 : p - hwv, hi_ = p + hwv - 1 > 63 ? 63 : p + hwv - 1; const float inv = __builtin_amdgcn_rcpf((float)(hi_ - lo_ + 1));
                    o[p] = pk2(s0 * inv, s1 * inv);
                    const int pi = p + hw > 63 ? 63 : p + hw, po = p - hw < 0 ? 0 : p - hw; const float fi = p + hw <= 63 ? 1.0f : 0.0f, fo = p - hw >= 0 ? 1.0f : 0.0f;
                    const unsigned wi = *(const LAS unsigned*)(F.lds + base + pi * stride), wo = *(const LAS unsigned*)(F.lds + base + po * stride);
                    s0 += fi * bflo(wi) - fo * bflo(wo); s1 += fi * bfhi(wi) - fo * bfhi(wo);
                    if ((p & 7) == 7) __builtin_amdgcn_sched_barrier(0);
                }
#pragma unroll
                for (int p = 0; p < 64; ++p) *(LAS unsigned*)(F.lds + base + p * stride) = o[p];
                __syncthreads();
            }
#pragma unroll
            for (int j = 0; j < 16; ++j) { const int idx = F.tid + NTHR * j, token = idx >> 1, half = idx & 1;
                const v4u m = *(const LAS v4u*)(F.lds + (token >> 6) * PR + (token & 63) * 32 + half * 16);
                v4u ov; ov.x = pk2(bflo(m.x) - bflo(h[j].x), bfhi(m.x) - bfhi(h[j].x)); ov.y = pk2(bflo(m.y) - bflo(h[j].y), bfhi(m.y) - bfhi(h[j].y));
                ov.z = pk2(bflo(m.z) - bflo(h[j].z), bfhi(m.z) - bfhi(h[j].z)); ov.w = pk2(bflo(m.w) - bflo(h[j].w), bfhi(m.w) - bfhi(h[j].w));
                *(GAS v4u*)(dst + (size_t)token * DM + half * 8) = ov; }
        }
        __syncthreads();
    }
    SEAM(16);
    if (IN(18)) {
        struct PoolOrder {
            int G, c; const char* D; const char* W;
            __device__ __forceinline__ bool next(int i, pg8::Unit& u) const {
                const int L = i * G + c; if (L >= 512) return false;
                pg8::tile_of(L, 64, 8, u.pm, u.pn); const int g = u.pn >> 1; u.ty = 0;
                u.A = D + ((size_t)u.pm * 256 * DM + g * 512) * 2; u.B = W + ((size_t)g * 512 * 512 + (size_t)(u.pn & 1) * 256 * 512) * 2; return true;
            }
        } S{F.G, (int)blockIdx.x, (const char*)DD, (const char*)Wpool};
        pg8::Gemm g{512, DM, 512};
        pg8::EpiResid<false> E{XB, XB, (pg8::bf16_t*)XB, mod + ((size_t)(1 * 5) * 9 + 5) * DM, 9 * DM, args.in[I_POOLS], 1.0f};
        pg8::gemm_phase<pg8::EpiResid<false>, PoolOrder, true, true>(F.lds, g, S, E);
    }
    SEAM(18);
    if (IN(19)) norm_pass_h(F, XB, ML, mod, 1, 6, HN, F8_UP);
    SEAM(19);
    if (IN(20)) FFN_UP(3, ML);
    SEAM(20);
    if (IN(21)) FFN_DN(3, ML, false, XB, XB, 1, 8);
    SEAM(21);
    if (IN(22)) {
        { int row = F.gw; v4u vn[4];
          if (row < ML) {
#pragma unroll
              for (int q = 0; q < 4; ++q) vn[q] = *(const GAS v4u*)(XB + (size_t)row * DM + 8 * F.lane + 512 * q); }
          while (row < ML) {
            v4u v[4]; float s2 = 0.f;
#pragma unroll
            for (int q = 0; q < 4; ++q) v[q] = vn[q];
            const int rn = row + F.NGW;
            if (rn < ML) {
#pragma unroll
                for (int q = 0; q < 4; ++q) vn[q] = *(const GAS v4u*)(XB + (size_t)rn * DM + 8 * F.lane + 512 * q); }
            f32x4 x0[4], x1[4];
#pragma unroll
            for (int q = 0; q < 4; ++q) { x0[q] = (f32x4){bflo(v[q].x), bfhi(v[q].x), bflo(v[q].y), bfhi(v[q].y)}; x1[q] = (f32x4){bflo(v[q].z), bfhi(v[q].z), bflo(v[q].w), bfhi(v[q].w)};
                s2 += ((x0[q].x * x0[q].x + x0[q].y * x0[q].y) + (x0[q].z * x0[q].z + x0[q].w * x0[q].w)) + ((x1[q].x * x1[q].x + x1[q].y * x1[q].y) + (x1[q].z * x1[q].z + x1[q].w * x1[q].w)); }
            const float rstd = 1.0f / sqrtf(wave_sum(s2) * (1.0f / DM) + 1e-6f);
#pragma unroll
            for (int q = 0; q < 4; ++q) { const int col = 8 * F.lane + 512 * q;
                *(GAS f32x4*)(args.out + (size_t)row * DM + col) = x0[q] * rstd * *(const f32x4*)(args.in[I_FGAIN] + col);
                *(GAS f32x4*)(args.out + (size_t)row * DM + col + 4) = x1[q] * rstd * *(const f32x4*)(args.in[I_FGAIN] + col + 4); }
            row = rn;
          } }
    }
#undef IN
#undef SEAM
}

extern "C" void kernel_launch(void* const* d_in, const int* in_sizes, int n_in, void* d_out, int out_size, void* d_ws, size_t ws_size, hipStream_t stream) {
    static int grid = 0;
    if (grid == 0) {
        if (n_in != 29 || in_sizes[0] != ML * DM || out_size != ML * DM || ws_size < WS_END) { fprintf(stderr, "kernel_launch: unexpected shapes (n_in %d, ws %zu)\n", n_in, ws_size); grid = -1; return; }
        int dev = 0, cus = 0, per_cu = 0;
        if (hipGetDevice(&dev) != hipSuccess || hipDeviceGetAttribute(&cus, hipDeviceAttributeMultiprocessorCount, dev) != hipSuccess) { grid = -1; return; }
        if (hipFuncSetAttribute((const void*)mk_fwd, hipFuncAttributeMaxDynamicSharedMemorySize, LDS_BYTES) != hipSuccess) { grid = -1; return; }
        if (hipOccupancyMaxActiveBlocksPerMultiprocessor(&per_cu, (const void*)mk_fwd, NTHR, LDS_BYTES) != hipSuccess || per_cu < 1) { fprintf(stderr, "kernel_launch: occupancy query says %d\n", per_cu); }
        (void)hipGetLastError();
        grid = cus;
    }
    if (grid < 0) return;
    if (hipMemsetAsync((char*)d_ws + WS_CTL, 0, CTL_ZERO_BYTES, stream) != hipSuccess) return;
    Args a{};
    for (int i = 0; i < 29; ++i) a.in[i] = (const float*)d_in[i];
    a.out = (float*)d_out; a.ws = (unsigned char*)d_ws;
#if MK_PER_PHASE_LAUNCH
    for (int ph = 0; ph < NPHASE; ++ph) { a.ph_lo = ph; a.ph_hi = ph + 1; hipLaunchKernelGGL(mk_fwd, dim3(grid), dim3(NTHR), LDS_BYTES, stream, a); }
#else
    a.ph_lo = 0; a.ph_hi = NPHASE;
    hipLaunchKernelGGL(mk_fwd, dim3(grid), dim3(NTHR), LDS_BYTES, stream, a);
#endif
}
```

```cpp
#include <hip/hip_runtime.h>
#include <cstdio>
#include <cstdint>

#ifndef MK_PER_PHASE_LAUNCH
#define MK_PER_PHASE_LAUNCH 0
#endif
#ifndef F8_UP
#define F8_UP 1
#endif
#ifndef F8_DN
#define F8_DN 1
#endif
#ifndef DUP_PHASE
#define DUP_PHASE -1
#endif
#ifndef HY_NAIVE
#define HY_NAIVE 0
#endif

constexpr int NWAVES = 8, NTHR = 512;
constexpr int DM = 2048, NB = 4, SEQ = 4096, CTXL = 256;
constexpr int ML = NB * SEQ, MC = NB * CTXL, MA = ML + MC;
constexpr int DFF = 5632, NUP = 2 * DFF, MODW = 9 * DM;
constexpr int NPROJ = 7168, KS_MOD = 16;
constexpr int NPHASE = 23;

constexpr size_t MiB = 1u << 20;
constexpr size_t WS_CTL = 0, CTL_ZERO_BYTES = 1 * MiB;
constexpr size_t WS_MODP = 1 * MiB;
constexpr size_t WS_MOD = 13 * MiB;
constexpr size_t WS_A3 = 14 * MiB;
constexpr size_t WS_ROTC = 15 * MiB, WS_ROTS = 16 * MiB;
constexpr size_t WS_WUP = 17 * MiB;
constexpr size_t WS_WDN = 193 * MiB;
constexpr size_t WS_WIN = 281 * MiB;
constexpr size_t WS_WOUT = 309 * MiB;
constexpr size_t WS_WPOOL = 317 * MiB;
constexpr size_t WS_X = 319 * MiB;
constexpr size_t WS_HN = 455 * MiB;
constexpr size_t WS_HID = 523 * MiB;
constexpr size_t WS_QKVG = 523 * MiB;
constexpr size_t WS_KVC = 651 * MiB;
constexpr size_t WS_YHT = 655 * MiB;
constexpr size_t WS_TC = 523 * MiB;
constexpr size_t WS_DD = 587 * MiB;
constexpr size_t WS_PHT = 710 * MiB;
constexpr size_t WS_SPREV = 806 * MiB;
constexpr size_t WS_KR = 870 * MiB;
constexpr size_t WS_END = 902 * MiB;
constexpr int CW_TMO = 0, CW_BAR = 4096;

namespace pg8 {
#define PG8_LAS __attribute__((address_space(3)))
typedef unsigned short bf16_t;
typedef short bf16x8 __attribute__((ext_vector_type(8)));
typedef float f32x4 __attribute__((ext_vector_type(4)));
typedef unsigned u32x4 __attribute__((ext_vector_type(4)));
constexpr int BM = 256, BK = 64, HALF = 128, HTB = HALF * BK * 2, STAGE_BYTES = 8 * HTB, NXCD = 8, WGM = 4;

__host__ __device__ __forceinline__ int lds_byte(int r, int c) { const int st = (r >> 4) * 2 + (c >> 5), rr = r & 15, cc = c & 31, ob = rr * 64 + cc * 2; return st * 1024 + (ob ^ (((ob >> 9) & 1) << 5)); }
__host__ __device__ __forceinline__ void stage_rc(int b, int& R, int& C) { const int st = b / 1024, sb = b % 1024, swz = sb ^ (((sb >> 9) & 1) << 5); R = (st >> 1) * 16 + swz / 64; C = (st & 1) * 32 + (swz % 64) / 2; }
__host__ __device__ __forceinline__ int perm32(int rho) { const int n = rho >> 4, i = rho & 15; return 8 * (i >> 2) + 4 * n + (i & 3); }

struct Unit { int pm, pn, ty; const char* A; const char* B; };
struct Gemm { int K, lda, ldb; };

__device__ __forceinline__ void tile_of(int L, int nM, int nN, int& pm, int& pn) {
    const int nwg = nM * nN; int wgid = L;
    { const int q = nwg / NXCD, r = nwg % NXCD, xcd = wgid % NXCD, off = wgid / NXCD; wgid = (xcd < r ? xcd * (q + 1) : r * (q + 1) + (xcd - r) * q) + off; }
    const int nig = WGM * nN, gid = wgid / nig, fm = gid * WGM, gsz = (nM - fm) < WGM ? (nM - fm) : WGM;
    pm = fm + ((wgid % nig) % gsz); pn = (wgid % nig) / gsz;
}
struct StaticOrder {
    int nM, nN, nwg, G, c; const char* A; const char* B; size_t astep, bstep;
    __device__ void init(const void* A_, const void* B_, int M, int N, int lda, int ldb, int G_, int c_) { nM = M / BM; nN = N / BM; nwg = nM * nN; G = G_; c = c_; A = (const char*)A_; B = (const char*)B_; astep = (size_t)BM * lda * 2; bstep = (size_t)BM * ldb * 2; }
    __device__ __forceinline__ bool next(int i, Unit& u) const {
        const long L = (long)i * G + c; if (L >= nwg) return false;
        tile_of((int)L, nM, nN, u.pm, u.pn); u.ty = 0; u.A = A + (size_t)u.pm * astep; u.B = B + (size_t)u.pn * bstep; return true;
    }
};

__device__ __forceinline__ unsigned cvt_pk_bf16(float lo, float hi) { unsigned r; asm volatile("v_cvt_pk_bf16_f32 %0, %1, %2" : "=v"(r) : "v"(lo), "v"(hi)); return r; }
__device__ __forceinline__ float silu_f(float a) { return a * __builtin_amdgcn_rcpf(1.0f + __builtin_amdgcn_exp2f(-1.44269504089f * a)); }


typedef int i32x8 __attribute__((ext_vector_type(8)));
typedef int i32x4 __attribute__((ext_vector_type(4)));
__device__ __forceinline__ float clamp_f8(float v) { return __builtin_fminf(__builtin_fmaxf(v, -448.0f), 448.0f); }
__device__ __forceinline__ unsigned pack4_fp8(float a, float b, float c, float d) {
    int w = __builtin_amdgcn_cvt_pk_fp8_f32(clamp_f8(a), clamp_f8(b), 0, false); w = __builtin_amdgcn_cvt_pk_fp8_f32(clamp_f8(c), clamp_f8(d), w, true); return (unsigned)w; }
constexpr float F8S_ACT = 16.0f, F8S_WUP = 256.0f, F8S_HID = 8.0f, F8S_WDN = 512.0f;

template <bool F8OUT> struct EpiSwiglu {
    static constexpr bool PERM = true;
    void* H; int ldh; float dsc;
    __device__ __forceinline__ void operator()(const f32x4 (&acc)[2][2][4][2], const Unit& u, int wr, int wc, int fr, int fq) const {
        const int row0 = u.pm * BM + wr * 64 + fr, col0 = u.pn * HALF + wc * 32 + 8 * fq;
#pragma unroll
        for (int ai = 0; ai < 2; ++ai)
#pragma unroll
            for (int m = 0; m < 4; ++m) {
                const f32x4 a0 = acc[ai][0][m][0] * dsc, a1 = acc[ai][0][m][1] * dsc, b0 = acc[ai][1][m][0] * dsc, b1 = acc[ai][1][m][1] * dsc;
                if constexpr (F8OUT) {
                    typedef unsigned u32x2_ __attribute__((ext_vector_type(2)));
                    u32x2_ w8;
                    w8.x = pack4_fp8(silu_f(a0[0]) * b0[0] * F8S_HID, silu_f(a0[1]) * b0[1] * F8S_HID, silu_f(a0[2]) * b0[2] * F8S_HID, silu_f(a0[3]) * b0[3] * F8S_HID);
                    w8.y = pack4_fp8(silu_f(a1[0]) * b1[0] * F8S_HID, silu_f(a1[1]) * b1[1] * F8S_HID, silu_f(a1[2]) * b1[2] * F8S_HID, silu_f(a1[3]) * b1[3] * F8S_HID);
                    *(u32x2_*)((unsigned char*)H + (size_t)(row0 + ai * HALF + m * 16) * ldh + col0) = w8;
                    continue;
                }
                u32x4 w;
                w.x = cvt_pk_bf16(silu_f(a0[0]) * b0[0], silu_f(a0[1]) * b0[1]); w.y = cvt_pk_bf16(silu_f(a0[2]) * b0[2], silu_f(a0[3]) * b0[3]);
                w.z = cvt_pk_bf16(silu_f(a1[0]) * b1[0], silu_f(a1[1]) * b1[1]); w.w = cvt_pk_bf16(silu_f(a1[2]) * b1[2], silu_f(a1[3]) * b1[3]);
                *(u32x4*)((bf16_t*)H + (size_t)(row0 + ai * HALF + m * 16) * ldh + col0) = w;
            }
    }
};
template <bool BF32> struct EpiResid {
    static constexpr bool PERM = true;
    const void* base_lat; const void* base_ctx; bf16_t* out; const float* gate; int gate_rstride; const float* gate2; float fac;
    __device__ __forceinline__ void operator()(const f32x4 (&acc)[2][2][4][2], const Unit& u, int wr, int wc, int fr, int fq) const {
        const int row0 = u.pm * BM + wr * 64 + fr, col0 = u.pn * BM + wc * 32 + 8 * fq;
        const int rb = u.pm < 64 ? (u.pm >> 4) : 4;
        const float* g = gate + (size_t)rb * gate_rstride;
        f32x4 gv[2][2];
#pragma unroll
        for (int bj = 0; bj < 2; ++bj)
#pragma unroll
            for (int n = 0; n < 2; ++n) { gv[bj][n] = *(const f32x4*)(g + col0 + bj * HALF + n * 4) * fac; if (gate2) gv[bj][n] = gv[bj][n] * *(const f32x4*)(gate2 + col0 + bj * HALF + n * 4); }
#define RES_OFF(R) ((size_t)(row0 + ((R) >> 2) * HALF + ((R) & 3) * 16) * 2048 + col0)
        if constexpr (BF32) {
            const float* base = u.pm < 64 ? (const float*)base_lat : ((const float*)base_ctx - (size_t)16384 * 2048);
            constexpr int AH = 3;
            f32x4 bs[8][2][2];
#define RES_LOAD(R) do { const size_t off_ = RES_OFF(R); _Pragma("unroll") for (int bj = 0; bj < 2; ++bj) _Pragma("unroll") for (int n = 0; n < 2; ++n) bs[R][bj][n] = *(const f32x4*)(base + off_ + bj * HALF + n * 4); } while (0)
#pragma unroll
            for (int R = 0; R < AH; ++R) RES_LOAD(R);
            __builtin_amdgcn_sched_barrier(0);
#pragma unroll
            for (int R = 0; R < 8; ++R) {
                if (R + AH < 8) RES_LOAD(R + AH);
                __builtin_amdgcn_sched_barrier(0);
                const size_t off = RES_OFF(R);
#pragma unroll
                for (int bj = 0; bj < 2; ++bj) { const f32x4 o0 = bs[R][bj][0] + gv[bj][0] * acc[R >> 2][bj][R & 3][0], o1 = bs[R][bj][1] + gv[bj][1] * acc[R >> 2][bj][R & 3][1];
                    u32x4 w; w.x = cvt_pk_bf16(o0[0], o0[1]); w.y = cvt_pk_bf16(o0[2], o0[3]); w.z = cvt_pk_bf16(o1[0], o1[1]); w.w = cvt_pk_bf16(o1[2], o1[3]);
                    *(u32x4*)(out + off + bj * HALF) = w; }
                __builtin_amdgcn_sched_barrier(0);
            }
#undef RES_LOAD
        } else {
            const bf16_t* base = (const bf16_t*)base_lat;
            constexpr int AHB = 3;
            u32x4 bs[8][2];
#define RES_LOADB(R) do { const size_t off_ = RES_OFF(R); _Pragma("unroll") for (int bj = 0; bj < 2; ++bj) bs[R][bj] = *(const u32x4*)(base + off_ + bj * HALF); } while (0)
#pragma unroll
            for (int R = 0; R < AHB; ++R) RES_LOADB(R);
            __builtin_amdgcn_sched_barrier(0);
#pragma unroll
            for (int R = 0; R < 8; ++R) { if (R + AHB < 8) RES_LOADB(R + AHB);
                __builtin_amdgcn_sched_barrier(0);
                const size_t off = RES_OFF(R);
#pragma unroll
                for (int bj = 0; bj < 2; ++bj) { const u32x4 r = bs[R][bj];
                    const f32x4 b0 = (f32x4){__builtin_bit_cast(float, r.x << 16), __builtin_bit_cast(float, r.x & 0xffff0000u), __builtin_bit_cast(float, r.y << 16), __builtin_bit_cast(float, r.y & 0xffff0000u)};
                    const f32x4 b1 = (f32x4){__builtin_bit_cast(float, r.z << 16), __builtin_bit_cast(float, r.z & 0xffff0000u), __builtin_bit_cast(float, r.w << 16), __builtin_bit_cast(float, r.w & 0xffff0000u)};
                    const f32x4 o0 = b0 + gv[bj][0] * acc[R >> 2][bj][R & 3][0], o1 = b1 + gv[bj][1] * acc[R >> 2][bj][R & 3][1];
                    u32x4 w; w.x = cvt_pk_bf16(o0[0], o0[1]); w.y = cvt_pk_bf16(o0[2], o0[3]); w.z = cvt_pk_bf16(o1[0], o1[1]); w.w = cvt_pk_bf16(o1[2], o1[3]);
                    *(u32x4*)(out + off + bj * HALF) = w; }
                __builtin_amdgcn_sched_barrier(0);
            }
        }
#undef RES_LOADB
#undef RES_OFF
    }
};
struct EpiWin {
    static constexpr bool PERM = true;
    unsigned char* wsb; const float* rc; const float* rs;
    __device__ __forceinline__ void operator()(const f32x4 (&acc)[2][2][4][2], const Unit& u, int wr, int wc, int fr, int fq) const {
        const int row0 = u.pm * BM + wr * 64 + fr;
        const int ty = u.ty;
        if (ty == 0 || ty == 1 || (ty == 5 && u.pn < 4)) {
            const int hsel = wc >> 1, j0 = 32 * (wc & 1) + 8 * fq;
            const float sc = (ty == 0) ? 1.0f : 0.08838834764831845f;
            bf16_t* dst = (bf16_t*)(wsb + ((ty == 5) ? WS_KVC : WS_QKVG)); const int ld = (ty == 5) ? 2048 : 4096;
            const int cbase = u.pn * BM + hsel * 128 + j0;
#pragma unroll
            for (int ai = 0; ai < 2; ++ai)
#pragma unroll
                for (int m = 0; m < 4; ++m) {
                    const int r = row0 + ai * HALF + m * 16;
                    f32x4 c0 = (f32x4){1.f, 1.f, 1.f, 1.f}, c1 = c0, s0 = (f32x4){0.f, 0.f, 0.f, 0.f}, s1 = s0;
                    if (ty != 5) { const size_t ti = (size_t)(r & 4095) * 64 + j0; c0 = *(const f32x4*)(rc + ti); c1 = *(const f32x4*)(rc + ti + 4); s0 = *(const f32x4*)(rs + ti); s1 = *(const f32x4*)(rs + ti + 4); }
                    const f32x4 x10 = acc[ai][0][m][0] * sc, x11 = acc[ai][0][m][1] * sc, x20 = acc[ai][1][m][0] * sc, x21 = acc[ai][1][m][1] * sc;
                    const f32x4 o10 = x10 * c0 - x20 * s0, o11 = x11 * c1 - x21 * s1, o20 = x20 * c0 + x10 * s0, o21 = x21 * c1 + x11 * s1;
                    u32x4 w1, w2;
                    w1.x = cvt_pk_bf16(o10[0], o10[1]); w1.y = cvt_pk_bf16(o10[2], o10[3]); w1.z = cvt_pk_bf16(o11[0], o11[1]); w1.w = cvt_pk_bf16(o11[2], o11[3]);
                    w2.x = cvt_pk_bf16(o20[0], o20[1]); w2.y = cvt_pk_bf16(o20[2], o20[3]); w2.z = cvt_pk_bf16(o21[0], o21[1]); w2.w = cvt_pk_bf16(o21[2], o21[3]);
                    bf16_t* p = dst + (size_t)r * ld + cbase;
                    *(u32x4*)p = w1; *(u32x4*)(p + 64) = w2;
                }
        } else {
            bf16_t* dst = (bf16_t*)(wsb + ((ty == 4) ? WS_PHT : (ty == 5 ? WS_KVC : WS_QKVG))); const int ld = (ty == 4) ? 16384 : (ty == 5 ? 2048 : 4096);
            const int col0 = u.pn * BM + wc * 32 + 8 * fq;
#pragma unroll
            for (int ai = 0; ai < 2; ++ai)
#pragma unroll
                for (int m = 0; m < 4; ++m) { bf16_t* rowp = dst + (size_t)(row0 + ai * HALF + m * 16) * ld + col0;
#pragma unroll
                    for (int bj = 0; bj < 2; ++bj) { f32x4 v0 = acc[ai][bj][m][0], v1 = acc[ai][bj][m][1];
                        if (ty == 3) { v0 = (f32x4){silu_f(v0[0]), silu_f(v0[1]), silu_f(v0[2]), silu_f(v0[3])}; v1 = (f32x4){silu_f(v1[0]), silu_f(v1[1]), silu_f(v1[2]), silu_f(v1[3])}; }
                        u32x4 w; w.x = cvt_pk_bf16(v0[0], v0[1]); w.y = cvt_pk_bf16(v0[2], v0[3]); w.z = cvt_pk_bf16(v1[0], v1[1]); w.w = cvt_pk_bf16(v1[2], v1[3]);
                        *(u32x4*)(rowp + bj * HALF) = w; } }
        }
    }
};

template <class Epi, class Sched, bool ALIGN_EPI = false, bool SP2 = false, bool F8 = false>
__device__ __forceinline__ void gemm_phase(PG8_LAS unsigned char* lds, const Gemm g, const Sched& S, const Epi& E) {
    const int tid = threadIdx.x, wid = __builtin_amdgcn_readfirstlane(tid >> 6), lane = tid & 63, wr = wid >> 2, wc = wid & 3, fr = lane & 15, fq = lane >> 4;
    const int K = g.K, nt = K / BK;
    unsigned voffA[2], voffB[2];
#pragma unroll
    for (int i = 0; i < 2; ++i) { int R, C; stage_rc(tid * 16 + i * 8192, R, C); const int Rb = Epi::PERM ? ((R & ~31) + perm32(R & 31)) : R;
        voffA[i] = (unsigned)(R * g.lda + C) * 2u; voffB[i] = (unsigned)(Rb * g.ldb + C) * 2u; }
    const size_t kstep = (size_t)(BK * 2);
    const size_t hsA = (size_t)HALF * g.lda * 2, hsB = (size_t)HALF * g.ldb * 2;
    const unsigned ldsw = (unsigned)wid * 1024u;
    const int aoff = lds_byte(wr * 64 + fr, fq * 8), boff = lds_byte(wc * 32 + fr, fq * 8);
    const int a8o0 = lds_byte(wr * 64 + fr, 16 * fq + 8 * (fq & 1)), a8o1 = lds_byte(wr * 64 + fr, 16 * fq + 8 * (1 - (fq & 1)));
    const int b8o0 = lds_byte(wc * 32 + fr, 16 * fq + 8 * (fq & 1)), b8o1 = lds_byte(wc * 32 + fr, 16 * fq + 8 * (1 - (fq & 1)));
#define PG8_LDA8(dst, b, h) do { _Pragma("unroll") for (int m = 0; m < 4; ++m) { const i32x4 lo_ = *(const PG8_LAS i32x4*)(lds + PG8_SA(b, h) + a8o0 + m * 2048), hi_ = *(const PG8_LAS i32x4*)(lds + PG8_SA(b, h) + a8o1 + m * 2048); \
        dst[m] = __builtin_shufflevector(lo_, hi_, 0, 1, 2, 3, 4, 5, 6, 7); } } while (0)
#define PG8_LDB8(dst, b, h) do { _Pragma("unroll") for (int n = 0; n < 2; ++n) { const i32x4 lo_ = *(const PG8_LAS i32x4*)(lds + PG8_SB(b, h) + b8o0 + n * 2048), hi_ = *(const PG8_LAS i32x4*)(lds + PG8_SB(b, h) + b8o1 + n * 2048); \
        dst[n] = __builtin_shufflevector(lo_, hi_, 0, 1, 2, 3, 4, 5, 6, 7); } } while (0)
#define PG8_MMA8(ai, bj, At, Bt) do { __builtin_amdgcn_s_setprio(1); _Pragma("unroll") for (int m = 0; m < 4; ++m) _Pragma("unroll") for (int n = 0; n < 2; ++n) \
        asm volatile("v_mfma_scale_f32_16x16x128_f8f6f4 %0, %1, %2, %0, %3, %3 op_sel_hi:[0,0,0]" : "+v"(acc[ai][bj][m][n]) : "v"(Bt[n]), "v"(At[m]), "v"(f8scale)); __builtin_amdgcn_s_setprio(0); } while (0)
#define PG8_SA(b, h) (((b) * 2 + (h)) * HTB)
#define PG8_SB(b, h) ((4 + (b) * 2 + (h)) * HTB)
#define PG8_STAGE(bufoff, gbase, voff) do { _Pragma("unroll") for (int _i = 0; _i < 2; ++_i) \
        __builtin_amdgcn_global_load_lds((const unsigned*)((const char*)(gbase) + (voff)[_i]), (PG8_LAS unsigned*)(lds + (bufoff) + ldsw + _i * 8192), 16, 0, 0); } while (0)
#define PG8_LDA(dst, b, h) do { _Pragma("unroll") for (int m = 0; m < 4; ++m) _Pragma("unroll") for (int k = 0; k < 2; ++k) dst[m][k] = *(const PG8_LAS bf16x8*)(lds + PG8_SA(b, h) + aoff + m * 2048 + k * 1024); } while (0)
#define PG8_LDB(dst, b, h) do { _Pragma("unroll") for (int n = 0; n < 2; ++n) _Pragma("unroll") for (int k = 0; k < 2; ++k) dst[n][k] = *(const PG8_LAS bf16x8*)(lds + PG8_SB(b, h) + boff + n * 2048 + k * 1024); } while (0)
#define PG8_MMA(ai, bj, At, Bt) do { __builtin_amdgcn_s_setprio(1); _Pragma("unroll") for (int m = 0; m < 4; ++m) _Pragma("unroll") for (int n = 0; n < 2; ++n) _Pragma("unroll") for (int k = 0; k < 2; ++k) \
        acc[ai][bj][m][n] = __builtin_amdgcn_mfma_f32_16x16x32_bf16(Bt[n][k], At[m][k], acc[ai][bj][m][n], 0, 0, 0); __builtin_amdgcn_s_setprio(0); } while (0)
#define PG8_WAIT_V(n) asm volatile("s_waitcnt vmcnt(" #n ")" ::: "memory")
#define PG8_WAIT_L(n) asm volatile("s_waitcnt lgkmcnt(" #n ")" ::: "memory")
#define PG8_BAR __builtin_amdgcn_s_barrier()
#define PG8_SCHED __builtin_amdgcn_sched_barrier(0)
    Unit cur, nxt; int ui = 0;
    if (!S.next(0, cur)) return;
    f32x4 acc[2][2][4][2];
#pragma unroll
    for (int a = 0; a < 2; ++a)
#pragma unroll
        for (int b = 0; b < 2; ++b)
#pragma unroll
            for (int m = 0; m < 4; ++m)
#pragma unroll
                for (int n = 0; n < 2; ++n) acc[a][b][m][n] = (f32x4){0.f, 0.f, 0.f, 0.f};
    bf16x8 At[4][2], B0[2][2], B1[2][2];
    i32x8 At8[4], B08[2], B18[2];
    int f8scale = 0x7f7f7f7f; asm volatile("" : "+v"(f8scale));
    const char* cA = cur.A; const char* cB = cur.B;
    if constexpr (SP2) {
        PG8_STAGE(PG8_SB(0, 0), cB, voffB); PG8_STAGE(PG8_SB(0, 1), cB + hsB, voffB); PG8_STAGE(PG8_SA(0, 0), cA, voffA); PG8_STAGE(PG8_SA(0, 1), cA + hsA, voffA);
        if (wr == 1) PG8_BAR;
        PG8_WAIT_V(2); PG8_BAR;
        PG8_STAGE(PG8_SB(1, 0), cB + kstep, voffB); PG8_STAGE(PG8_SA(1, 0), cA + kstep, voffA); PG8_STAGE(PG8_SB(1, 1), cB + hsB + kstep, voffB);
        PG8_WAIT_V(6); PG8_BAR;
    } else {
        PG8_STAGE(PG8_SB(0, 0), cB, voffB); PG8_STAGE(PG8_SA(0, 0), cA, voffA); PG8_STAGE(PG8_SB(0, 1), cB + hsB, voffB); PG8_STAGE(PG8_SA(0, 1), cA + hsA, voffA);
        if (wr == 1) PG8_BAR;
        PG8_WAIT_V(4); PG8_BAR;
        PG8_STAGE(PG8_SB(1, 0), cB + kstep, voffB); PG8_STAGE(PG8_SA(1, 0), cA + kstep, voffA); PG8_STAGE(PG8_SB(1, 1), cB + hsB + kstep, voffB);
        PG8_WAIT_V(6); PG8_BAR;
    }
    for (;;) {
        const bool has_next = S.next(ui + 1, nxt);
        const char* nA = has_next ? nxt.A : cA; const char* nB = has_next ? nxt.B : cB;
        for (int t = 0; t < nt; t += 2) {
            const bool last = (t == nt - 2);
            const char* a1 = cA + (size_t)(t + 1) * kstep;
            const char* a2 = last ? nA : cA + (size_t)(t + 2) * kstep; const char* b2 = last ? nB : cB + (size_t)(t + 2) * kstep;
            const char* a3 = a2 + kstep; const char* b3 = b2 + kstep;
            if constexpr (SP2 && F8) {
            PG8_LDB8(B08, 0, 0); PG8_LDB8(B18, 0, 1); PG8_SCHED; PG8_LDA8(At8, 0, 0); PG8_STAGE(PG8_SA(1, 1), a1 + hsA, voffA);
            PG8_WAIT_V(8); PG8_WAIT_L(0); PG8_BAR; PG8_MMA8(0, 0, At8, B08); PG8_MMA8(0, 1, At8, B18); PG8_BAR; PG8_SCHED;
            PG8_LDA8(At8, 0, 1); PG8_STAGE(PG8_SB(0, 0), b2, voffB); PG8_STAGE(PG8_SB(0, 1), b2 + hsB, voffB); PG8_STAGE(PG8_SA(0, 0), a2, voffA);
            PG8_WAIT_V(8); PG8_WAIT_L(0); PG8_BAR; PG8_MMA8(1, 0, At8, B08); PG8_MMA8(1, 1, At8, B18); PG8_BAR; PG8_SCHED;
            PG8_LDB8(B08, 1, 0); PG8_LDB8(B18, 1, 1); PG8_SCHED; PG8_LDA8(At8, 1, 0); PG8_STAGE(PG8_SA(0, 1), a2 + hsA, voffA);
            PG8_WAIT_V(8); PG8_WAIT_L(0); PG8_BAR; PG8_MMA8(0, 0, At8, B08); PG8_MMA8(0, 1, At8, B18); PG8_BAR; PG8_SCHED;
            PG8_LDA8(At8, 1, 1); PG8_STAGE(PG8_SB(1, 0), b3, voffB); PG8_STAGE(PG8_SB(1, 1), b3 + hsB, voffB); PG8_STAGE(PG8_SA(1, 0), a3, voffA);
            PG8_WAIT_V(8); PG8_WAIT_L(0); PG8_BAR; PG8_MMA8(1, 0, At8, B08); PG8_MMA8(1, 1, At8, B18); PG8_BAR; PG8_SCHED;
            } else if constexpr (SP2) {
            PG8_LDB(B0, 0, 0); PG8_LDB(B1, 0, 1); PG8_SCHED; PG8_LDA(At, 0, 0); PG8_STAGE(PG8_SA(1, 1), a1 + hsA, voffA);
            PG8_WAIT_V(8); PG8_WAIT_L(0); PG8_BAR; PG8_MMA(0, 0, At, B0); PG8_MMA(0, 1, At, B1); PG8_BAR; PG8_SCHED;
            PG8_LDA(At, 0, 1); PG8_STAGE(PG8_SB(0, 0), b2, voffB); PG8_STAGE(PG8_SB(0, 1), b2 + hsB, voffB); PG8_STAGE(PG8_SA(0, 0), a2, voffA);
            PG8_WAIT_V(8); PG8_WAIT_L(0); PG8_BAR; PG8_MMA(1, 0, At, B0); PG8_MMA(1, 1, At, B1); PG8_BAR; PG8_SCHED;
            PG8_LDB(B0, 1, 0); PG8_LDB(B1, 1, 1); PG8_SCHED; PG8_LDA(At, 1, 0); PG8_STAGE(PG8_SA(0, 1), a2 + hsA, voffA);
            PG8_WAIT_V(8); PG8_WAIT_L(0); PG8_BAR; PG8_MMA(0, 0, At, B0); PG8_MMA(0, 1, At, B1); PG8_BAR; PG8_SCHED;
            PG8_LDA(At, 1, 1); PG8_STAGE(PG8_SB(1, 0), b3, voffB); PG8_STAGE(PG8_SB(1, 1), b3 + hsB, voffB); PG8_STAGE(PG8_SA(1, 0), a3, voffA);
            PG8_WAIT_V(8); PG8_WAIT_L(0); PG8_BAR; PG8_MMA(1, 0, At, B0); PG8_MMA(1, 1, At, B1); PG8_BAR; PG8_SCHED;
            } else {
            PG8_LDB(B0, 0, 0); PG8_SCHED; PG8_LDA(At, 0, 0); PG8_STAGE(PG8_SA(1, 1), a1 + hsA, voffA);
            PG8_WAIT_L(8); PG8_BAR; PG8_WAIT_L(0); PG8_MMA(0, 0, At, B0); PG8_BAR; PG8_SCHED;
            PG8_LDB(B1, 0, 1); PG8_STAGE(PG8_SB(0, 0), b2, voffB);
            PG8_BAR; PG8_WAIT_L(0); PG8_MMA(0, 1, At, B1); PG8_BAR;
            PG8_LDA(At, 0, 1); PG8_STAGE(PG8_SA(0, 0), a2, voffA);
            PG8_BAR; PG8_WAIT_L(0); PG8_MMA(1, 0, At, B0); PG8_BAR; PG8_SCHED;
            PG8_STAGE(PG8_SB(0, 1), b2 + hsB, voffB);
            PG8_WAIT_V(6); PG8_BAR; PG8_MMA(1, 1, At, B1); PG8_BAR;
            PG8_LDB(B0, 1, 0); PG8_SCHED; PG8_LDA(At, 1, 0); PG8_STAGE(PG8_SA(0, 1), a2 + hsA, voffA);
            PG8_WAIT_L(8); PG8_BAR; PG8_WAIT_L(0); PG8_MMA(0, 0, At, B0); PG8_BAR; PG8_SCHED;
            PG8_LDB(B1, 1, 1); PG8_STAGE(PG8_SB(1, 0), b3, voffB);
            PG8_BAR; PG8_WAIT_L(0); PG8_MMA(0, 1, At, B1); PG8_BAR;
            PG8_LDA(At, 1, 1); PG8_STAGE(PG8_SA(1, 0), a3, voffA);
            PG8_BAR; PG8_WAIT_L(0); PG8_MMA(1, 0, At, B0); PG8_BAR; PG8_SCHED;
            PG8_STAGE(PG8_SB(1, 1), b3 + hsB, voffB);
            PG8_WAIT_V(6); PG8_BAR; PG8_MMA(1, 1, At, B1); PG8_BAR;
            }
        }
        if constexpr (ALIGN_EPI) { if (wr == 0) PG8_BAR; }
        if constexpr (F8) asm volatile("s_nop 15\n\ts_nop 15" ::: "memory");
        E(acc, cur, wr, wc, fr, fq);
        if (!has_next) break;
#pragma unroll
        for (int a = 0; a < 2; ++a)
#pragma unroll
            for (int b = 0; b < 2; ++b)
#pragma unroll
                for (int m = 0; m < 4; ++m)
#pragma unroll
                    for (int n = 0; n < 2; ++n) acc[a][b][m][n] = (f32x4){0.f, 0.f, 0.f, 0.f};
        cur = nxt; cA = nA; cB = nB; ++ui;
        if constexpr (ALIGN_EPI) { if (wr == 1) PG8_BAR; }
    }
    PG8_WAIT_V(0);
    if constexpr (!ALIGN_EPI) { if (wr == 0) PG8_BAR; }
    PG8_BAR;
#undef PG8_LDA8
#undef PG8_LDB8
#undef PG8_MMA8
#undef PG8_SA
#undef PG8_SB
#undef PG8_STAGE
#undef PG8_LDA
#undef PG8_LDB
#undef PG8_MMA
#undef PG8_WAIT_V
#undef PG8_WAIT_L
#undef PG8_BAR
#undef PG8_SCHED
}
}

constexpr int LDS_BYTES = 147456;
constexpr int MISC_OFF = LDS_BYTES - 256;

#define GAS __attribute__((address_space(1)))
#define LAS __attribute__((address_space(3)))
typedef unsigned short bf16;
typedef unsigned v4u __attribute__((ext_vector_type(4)));
typedef unsigned v2u __attribute__((ext_vector_type(2)));
typedef float f32x4 __attribute__((ext_vector_type(4)));
typedef short bf16x8 __attribute__((ext_vector_type(8)));
typedef short s16x4 __attribute__((ext_vector_type(4)));
typedef GAS unsigned gu32;
#define RLX_AGENT __ATOMIC_RELAXED, __HIP_MEMORY_SCOPE_AGENT
#define LDS_WAIT() asm volatile("s_waitcnt lgkmcnt(0)" ::: "memory")
#define LDS_BARRIER() asm volatile("s_waitcnt lgkmcnt(0)\n\ts_barrier" ::: "memory")
#define VM_WAIT() asm volatile("s_waitcnt vmcnt(0)" ::: "memory")
__device__ __forceinline__ unsigned pk2(float lo, float hi) { unsigned r; asm("v_cvt_pk_bf16_f32 %0, %1, %2" : "=v"(r) : "v"(lo), "v"(hi)); return r; }
__device__ __forceinline__ unsigned f2bf(float f) { return pk2(f, 0.0f) & 0xffffu; }
__device__ __forceinline__ float bf2f(unsigned short b) { return __builtin_bit_cast(float, (unsigned)b << 16); }
__device__ __forceinline__ float bflo(unsigned w) { return __builtin_bit_cast(float, w << 16); }
__device__ __forceinline__ float bfhi(unsigned w) { return __builtin_bit_cast(float, w & 0xffff0000u); }
__device__ __forceinline__ float fexp(float x) { return __builtin_amdgcn_exp2f(x * 1.44269504089f); }
__device__ __forceinline__ float wave_sum(float v) {
#pragma unroll
    for (int o = 1; o < 64; o <<= 1) v += __shfl_xor(v, o);
    return v;
}

#define XB_TMO      128
#define XB_XCNT(j)  (256  + 64 * (j))
#define XB_XSUB(j)  (1280 + 64 * (j))
#define XB_XGEN(j)  (2304 + 64 * (j))
#define XB_TOP      3328
#define XB_TOPGEN   3392
#define XCD_BAR_WORDS 3456
#define XB_SPIN_CAP (1u << 21)
__device__ __forceinline__ unsigned xb_ld(unsigned* p)              { return __hip_atomic_load(p, __ATOMIC_RELAXED, __HIP_MEMORY_SCOPE_AGENT); }
__device__ __forceinline__ unsigned xb_add(unsigned* p, unsigned v) { return __hip_atomic_fetch_add(p, v, __ATOMIC_RELAXED, __HIP_MEMORY_SCOPE_AGENT); }
__device__ __forceinline__ unsigned xb_xcc_id() { return (unsigned)__builtin_amdgcn_s_getreg((3 << 11) | 20) & 0xFu; }
#define XB_SPIN(cond, bar) do { unsigned _sp = 0; while (cond) { __builtin_amdgcn_s_sleep(1); \
    if ((++_sp & 255u) == 0u) { if (xb_ld(&(bar)[XB_TMO])) break; if (_sp > XB_SPIN_CAP) { atomicAdd(&(bar)[XB_TMO], 1u); break; } } } } while (0)
struct XcdBarrier { unsigned* bar; unsigned x; volatile LAS unsigned* st; };
__device__ __forceinline__ XcdBarrier xcd_barrier_post(unsigned* bar, volatile LAS unsigned* st) {
    XcdBarrier b; b.bar = bar; b.x = xb_xcc_id(); b.st = st;
    if (threadIdx.x == 0) (void)xb_add(&bar[XB_XCNT(b.x)], 1u);
    return b;
}
__device__ __forceinline__ void xcd_barrier_complete(unsigned* bar, unsigned x, unsigned& nloc, unsigned& nx) {
    const unsigned G = gridDim.x * gridDim.y * gridDim.z;
    unsigned sum, cnt, mine, sp = 0u;
    for (;;) {
        sum = 0u; cnt = 0u; mine = 0u;
#pragma unroll
        for (unsigned j = 0; j < 16; ++j) { const unsigned c = xb_ld(&bar[XB_XCNT(j)]); sum += c; cnt += (c > 0u) ? 1u : 0u; mine = (j == x) ? c : mine; }
        if (sum == G) break;
        __builtin_amdgcn_s_sleep(1);
        if ((++sp & 255u) == 0u) { if (xb_ld(&bar[XB_TMO])) break; if (sp > XB_SPIN_CAP) { atomicAdd(&bar[XB_TMO], 1u); break; } }
    }
    nloc = mine > 0u ? mine : 1u; nx = cnt > 0u ? cnt : 1u;
}
__device__ __forceinline__ void xcd_barrier(const XcdBarrier& b) {
    asm volatile("s_waitcnt vmcnt(0)" ::: "memory");
    __syncthreads();
    if (threadIdx.x == 0) {
        unsigned* bar = b.bar;
        __builtin_amdgcn_s_waitcnt(0);
        unsigned nloc = b.st[0], nx = b.st[1];
        if (nloc == 0u) { xcd_barrier_complete(bar, b.x, nloc, nx); b.st[0] = nloc; b.st[1] = nx; }
        const unsigned old = xb_add(&bar[XB_XSUB(b.x)], 1u);
        const unsigned gen = old / nloc;
        if (old + 1u == (gen + 1u) * nloc) {
            __builtin_amdgcn_fence(__ATOMIC_RELEASE, "agent");
            asm volatile("s_waitcnt vmcnt(0)" ::: "memory");
            const unsigned og = xb_add(&bar[XB_TOP], 1u);
            const unsigned tg = og / nx;
            if (og + 1u == (tg + 1u) * nx) xb_add(&bar[XB_TOPGEN], 1u);
            else XB_SPIN(xb_ld(&bar[XB_TOPGEN]) == tg, bar);
            __builtin_amdgcn_fence(__ATOMIC_ACQUIRE, "agent");
            xb_add(&bar[XB_XGEN(b.x)], 1u);
            asm volatile("s_waitcnt vmcnt(0)" ::: "memory");
        } else {
            XB_SPIN(xb_ld(&bar[XB_XGEN(b.x)]) == gen, bar);
            __builtin_amdgcn_fence(__ATOMIC_ACQUIRE, "agent");
            asm volatile("s_waitcnt vmcnt(0)" ::: "memory");
        }
    }
    __syncthreads();
}

struct Args { const float* in[29]; float* out; unsigned char* ws; int ph_lo, ph_hi; };
enum { I_X = 0, I_C, I_CTX, I_CCTX, I_WMOD, I_BMOD, I_F1W1, I_F1W3, I_F1W2, I_F2W1, I_F2W3, I_F2W2, I_WIN, I_WOUT, I_LOGD, I_CONVW, I_CONVB,
       I_FW1, I_FB1, I_FW2, I_FB2, I_FW3, I_FB3, I_FREQ, I_FW4, I_HYB, I_POOLW, I_POOLS, I_FGAIN };

struct Frame {
    LAS unsigned char* lds;
    int tid, lane, wave, G, gw, NGW;
};

__device__ __forceinline__ void conv_item(const float* W, int N, bf16* WT, int K, int k0, int n0, int drow, int lane) {
    const float* p = W + (size_t)k0 * N + n0 + lane;
    float v[64];
#pragma unroll
    for (int i = 0; i < 64; ++i) v[i] = __builtin_nontemporal_load((const GAS float*)(p + (size_t)i * N));
    bf16* o = WT + (size_t)drow * K + k0;
#pragma unroll
    for (int q = 0; q < 8; ++q) { v4u w; w.x = pk2(v[8 * q], v[8 * q + 1]); w.y = pk2(v[8 * q + 2], v[8 * q + 3]); w.z = pk2(v[8 * q + 4], v[8 * q + 5]); w.w = pk2(v[8 * q + 6], v[8 * q + 7]);
        *(GAS v4u*)(o + 8 * q) = w; }
}
__device__ __forceinline__ void conv_item8(const float* W, int N, unsigned char* WT, int Kb, int k0, int n0, int drow, float scale, int lane) {
    const float* p = W + (size_t)k0 * N + n0 + lane;
    float v[64];
#pragma unroll
    for (int i = 0; i < 64; ++i) v[i] = __builtin_nontemporal_load((const GAS float*)(p + (size_t)i * N));
    unsigned char* o = WT + (size_t)drow * Kb + k0;
#pragma unroll
    for (int q = 0; q < 4; ++q) { v4u w;
        w.x = pg8::pack4_fp8(v[16 * q] * scale, v[16 * q + 1] * scale, v[16 * q + 2] * scale, v[16 * q + 3] * scale); w.y = pg8::pack4_fp8(v[16 * q + 4] * scale, v[16 * q + 5] * scale, v[16 * q + 6] * scale, v[16 * q + 7] * scale);
        w.z = pg8::pack4_fp8(v[16 * q + 8] * scale, v[16 * q + 9] * scale, v[16 * q + 10] * scale, v[16 * q + 11] * scale); w.w = pg8::pack4_fp8(v[16 * q + 12] * scale, v[16 * q + 13] * scale, v[16 * q + 14] * scale, v[16 * q + 15] * scale);
        *(GAS v4u*)(o + 16 * q) = w; }
}

__device__ __forceinline__ f32x4 mod_from_partials(const float* modp, const float* bmod, int layer, int r, int col) {
    f32x4 s = *(const f32x4*)(bmod + (size_t)layer * MODW + col);
#pragma unroll 4
    for (int ks = 0; ks < KS_MOD; ++ks) s += *(const f32x4*)(modp + ((size_t)((ks * 2 + layer) * 5 + r)) * MODW + col);
    return s;
}

__device__ __forceinline__ void norm_pass(Frame& F, const float* src_lat, const float* src_ctx, int nrows, const float* mod, const float* modp, const float* bmod, int layer, int j, bf16* HNo, bool f8out) {
    LAS float* SS = (LAS float*)F.lds;
    const int per = nrows / F.G, rbeg = blockIdx.x * per, rend = rbeg + per;
    int sbeg = rbeg;
    while (sbeg < rend) {
        const int rb = sbeg < ML ? sbeg / SEQ : 4;
        int send = sbeg < ML ? (rb + 1) * SEQ : rend; if (send > rend) send = rend;
        __syncthreads();
        for (int c4 = F.tid; c4 < 2 * DM / 4; c4 += NTHR) { const int which = c4 / (DM / 4), col = (c4 % (DM / 4)) * 4;
            f32x4 v = modp ? mod_from_partials(modp, bmod, layer, rb, (j + which) * DM + col) : *(const f32x4*)(mod + ((size_t)(layer * 5 + rb) * 9 + j + which) * DM + col);
            *(LAS f32x4*)(SS + which * DM + col) = v; }
        __syncthreads();
        int row = sbeg + F.wave;
        f32x4 vn[8];
        if (row < send) { const float* xr = row < ML ? src_lat + (size_t)row * DM : src_ctx + (size_t)(row - ML) * DM;
#pragma unroll
            for (int q = 0; q < 8; ++q) vn[q] = *(const GAS f32x4*)(xr + 4 * F.lane + 256 * q); }
        while (row < send) {
            f32x4 v[8]; float s2 = 0.f;
#pragma unroll
            for (int q = 0; q < 8; ++q) v[q] = vn[q];
            const int rn = row + NWAVES;
            if (rn < send) { const float* xr = rn < ML ? src_lat + (size_t)rn * DM : src_ctx + (size_t)(rn - ML) * DM;
#pragma unroll
                for (int q = 0; q < 8; ++q) vn[q] = *(const GAS f32x4*)(xr + 4 * F.lane + 256 * q); }
#pragma unroll
            for (int q = 0; q < 8; ++q) s2 += (v[q].x * v[q].x + v[q].y * v[q].y) + (v[q].z * v[q].z + v[q].w * v[q].w);
            const float rstd = 1.0f / sqrtf(wave_sum(s2) * (1.0f / DM) + 1e-6f);
            bf16* orow = HNo + (size_t)row * DM;
#pragma unroll
            for (int q = 0; q < 8; ++q) { const int col = 4 * F.lane + 256 * q; const f32x4 sh = *(const LAS f32x4*)(SS + col), sc = *(const LAS f32x4*)(SS + DM + col);
                const f32x4 o = v[q] * rstd * (sc + 1.0f) + sh;
                if (f8out) { *(GAS unsigned*)((unsigned char*)HNo + (size_t)row * DM + col) = pg8::pack4_fp8(o.x * pg8::F8S_ACT, o.y * pg8::F8S_ACT, o.z * pg8::F8S_ACT, o.w * pg8::F8S_ACT); }
                else { v2u w; w.x = pk2(o.x, o.y); w.y = pk2(o.z, o.w); *(GAS v2u*)(orow + col) = w; } }
            row = rn;
        }
        sbeg = send;
    }
    __syncthreads();
}

__device__ __forceinline__ void norm_pass_h(Frame& F, const bf16* XHs, int nrows, const float* mod, int layer, int j, bf16* HNo, bool f8out, const float* modp = nullptr, const float* bmod = nullptr) {
    LAS float* SS = (LAS float*)F.lds;
    const int per = nrows / F.G, rbeg = blockIdx.x * per, rend = rbeg + per;
    int sbeg = rbeg;
    while (sbeg < rend) {
        const int rb = sbeg < ML ? sbeg / SEQ : 4;
        int send = sbeg < ML ? (rb + 1) * SEQ : rend; if (send > rend) send = rend;
        __syncthreads();
        for (int c4 = F.tid; c4 < 2 * DM / 4; c4 += NTHR) { const int which = c4 / (DM / 4), col = (c4 % (DM / 4)) * 4;
            *(LAS f32x4*)(SS + which * DM + col) = modp ? mod_from_partials(modp, bmod, layer, rb, (j + which) * DM + col) : *(const f32x4*)(mod + ((size_t)(layer * 5 + rb) * 9 + j + which) * DM + col); }
        __syncthreads();
        int row = sbeg + F.wave;
        v4u vn[4];
        if (row < send) {
#pragma unroll
            for (int q = 0; q < 4; ++q) vn[q] = *(const GAS v4u*)(XHs + (size_t)row * DM + 8 * F.lane + 512 * q); }
        while (row < send) {
            v4u v[4]; float s2 = 0.f;
#pragma unroll
            for (int q = 0; q < 4; ++q) v[q] = vn[q];
            const int rn = row + NWAVES;
            if (rn < send) {
#pragma unroll
                for (int q = 0; q < 4; ++q) vn[q] = *(const GAS v4u*)(XHs + (size_t)rn * DM + 8 * F.lane + 512 * q); }
            f32x4 x0[4], x1[4];
#pragma unroll
            for (int q = 0; q < 4; ++q) { x0[q] = (f32x4){bflo(v[q].x), bfhi(v[q].x), bflo(v[q].y), bfhi(v[q].y)}; x1[q] = (f32x4){bflo(v[q].z), bfhi(v[q].z), bflo(v[q].w), bfhi(v[q].w)};
                s2 += ((x0[q].x * x0[q].x + x0[q].y * x0[q].y) + (x0[q].z * x0[q].z + x0[q].w * x0[q].w)) + ((x1[q].x * x1[q].x + x1[q].y * x1[q].y) + (x1[q].z * x1[q].z + x1[q].w * x1[q].w)); }
            const float rstd = 1.0f / sqrtf(wave_sum(s2) * (1.0f / DM) + 1e-6f);
#pragma unroll
            for (int q = 0; q < 4; ++q) { const int col = 8 * F.lane + 512 * q;
                const f32x4 o0 = x0[q] * rstd * (*(const LAS f32x4*)(SS + DM + col) + 1.0f) + *(const LAS f32x4*)(SS + col);
                const f32x4 o1 = x1[q] * rstd * (*(const LAS f32x4*)(SS + DM + col + 4) + 1.0f) + *(const LAS f32x4*)(SS + col + 4);
                if (f8out) { v2u w; w.x = pg8::pack4_fp8(o0.x * pg8::F8S_ACT, o0.y * pg8::F8S_ACT, o0.z * pg8::F8S_ACT, o0.w * pg8::F8S_ACT); w.y = pg8::pack4_fp8(o1.x * pg8::F8S_ACT, o1.y * pg8::F8S_ACT, o1.z * pg8::F8S_ACT, o1.w * pg8::F8S_ACT);
                    *(GAS v2u*)((unsigned char*)HNo + (size_t)row * DM + col) = w; }
                else { v4u w; w.x = pk2(o0.x, o0.y); w.y = pk2(o0.z, o0.w); w.z = pk2(o1.x, o1.y); w.w = pk2(o1.z, o1.w); *(GAS v4u*)(HNo + (size_t)row * DM + col) = w; } }
            row = rn;
        }
        sbeg = send;
    }
    __syncthreads();
}

__global__ void __launch_bounds__(NTHR, 2) mk_fwd(Args args) {
    extern __shared__ __attribute__((aligned(16))) unsigned char lds_raw[];
    Frame F;
    F.lds = (LAS unsigned char*)lds_raw;
    volatile LAS unsigned* MISC = (volatile LAS unsigned*)(F.lds + MISC_OFF);
    F.tid = threadIdx.x; F.lane = F.tid & 63; F.wave = __builtin_amdgcn_readfirstlane(F.tid >> 6);
    F.G = gridDim.x; F.gw = blockIdx.x * NWAVES + F.wave; F.NGW = F.G * NWAVES;
    unsigned char* ws = args.ws;
    gu32* ctl = (gu32*)(ws + WS_CTL);
    if (F.tid < 64) MISC[F.tid] = 0u;
    __syncthreads();
    XcdBarrier bar; bar.bar = (unsigned*)(ctl + CW_BAR); bar.x = 0; bar.st = nullptr;
    const int lo = args.ph_lo, hi = args.ph_hi;
    if (hi - lo > 1) bar = xcd_barrier_post((unsigned*)(ctl + CW_BAR), MISC + 8);
#define IN(k) (lo <= (k) && (k) < hi)
#define REP(k) for (int rep_ = 0; rep_ < ((DUP_PHASE) == (k) ? 2 : 1); ++rep_)
#define SEAM(k) do { if (IN(k) && IN((k) + 1)) xcd_barrier(bar); } while (0)

    float* modp = (float*)(ws + WS_MODP); float* mod = (float*)(ws + WS_MOD);
    float* A3 = (float*)(ws + WS_A3); float* rotc = (float*)(ws + WS_ROTC); float* rots = (float*)(ws + WS_ROTS);
    bf16* Wup = (bf16*)(ws + WS_WUP); bf16* Wdn = (bf16*)(ws + WS_WDN); bf16* Win = (bf16*)(ws + WS_WIN); bf16* Wout = (bf16*)(ws + WS_WOUT); bf16* Wpool = (bf16*)(ws + WS_WPOOL);
    bf16* XB = (bf16*)(ws + WS_X);
    bf16* HN = (bf16*)(ws + WS_HN); bf16* HID = (bf16*)(ws + WS_HID);
    bf16* QKVG = (bf16*)(ws + WS_QKVG); bf16* KVC = (bf16*)(ws + WS_KVC); bf16* YHT = (bf16*)(ws + WS_YHT); bf16* PHT = (bf16*)(ws + WS_PHT);
    bf16* SPREV = (bf16*)(ws + WS_SPREV); bf16* KR = (bf16*)(ws + WS_KR); bf16* TC = (bf16*)(ws + WS_TC); bf16* DD = (bf16*)(ws + WS_DD);
    bf16* A2 = HN;
    const size_t UPSZ = (size_t)NUP * DM, DNSZ = (size_t)DM * DFF;

    constexpr int NI_UP = 32 * 88, NI_DN = 88 * 32, NI_WIN = 32 * 112, NI_WOUT = 32 * 32, NI_POOL = 8 * 8;
    constexpr int CV_P0UP = 2 * NI_UP, CV_P0 = 2 * NI_UP + NI_DN, CV_N0 = 2 * NI_UP + NI_DN + NI_WOUT, CV_N1A = NI_WIN + 2 * NI_UP + NI_DN, CV_N1B = 2 * (2 * NI_UP + NI_DN) + 4 * NI_POOL;
#define CONVERT_ITEM(IT) do { int r = (IT); int kind = -1, m8 = 0, fd = 0; \
        if (r < 2 * NI_UP) { kind = 0; m8 = r / NI_UP; r %= NI_UP; } else { r -= 2 * NI_UP; \
        if (r < NI_DN) { kind = 1; fd = 0; } else { r -= NI_DN; \
        if (r < NI_WOUT) { kind = 3; } else { r -= NI_WOUT; \
        if (r < NI_WIN) { kind = 2; } else { r -= NI_WIN; \
        if (r < 2 * NI_UP) { kind = 0; m8 = 4 + r / NI_UP; r %= NI_UP; } else { r -= 2 * NI_UP; \
        if (r < NI_DN) { kind = 1; fd = 2; } else { r -= NI_DN; \
        if (r < 2 * NI_UP) { kind = 0; m8 = 2 + r / NI_UP; r %= NI_UP; } else { r -= 2 * NI_UP; \
        if (r < NI_DN) { kind = 1; fd = 1; } else { r -= NI_DN; \
        if (r < 2 * NI_UP) { kind = 0; m8 = 6 + r / NI_UP; r %= NI_UP; } else { r -= 2 * NI_UP; \
        if (r < NI_DN) { kind = 1; fd = 3; } else { r -= NI_DN; kind = 4; } } } } } } } } } } \
        if (kind == 0) { const int f = m8 >> 1, half = m8 & 1, kb = r / 88, nb = r % 88, n0 = nb * 64, n = n0 + F.lane, dr = (n >> 7) * 256 + half * 128 + (n & 127); \
            const float* src = args.in[(f & 1) ? (half ? I_F2W3 : I_F2W1) : (half ? I_F1W3 : I_F1W1)] + (size_t)(f >> 1) * DM * DFF; \
            if (F8_UP) conv_item8(src, DFF, (unsigned char*)(Wup + f * UPSZ), DM, kb * 64, n0, dr, pg8::F8S_WUP, F.lane); \
            else conv_item(src, DFF, Wup + f * UPSZ, DM, kb * 64, n0, dr, F.lane); } \
        else if (kind == 1) { const int kb = r / 32, nb = r % 32; const float* src = args.in[(fd & 1) ? I_F2W2 : I_F1W2] + (size_t)(fd >> 1) * DFF * DM; \
            if (F8_DN) conv_item8(src, DM, (unsigned char*)(Wdn + fd * DNSZ), DFF, kb * 64, nb * 64, nb * 64 + F.lane, pg8::F8S_WDN, F.lane); \
            else conv_item(src, DM, Wdn + fd * DNSZ, DFF, kb * 64, nb * 64, nb * 64 + F.lane, F.lane); } \
        else if (kind == 2) { const int kb = r / 112, nb = r % 112, n0 = nb * 64, n = n0 + F.lane; int dr = n; \
            if (n0 < 2048) { const int tile = n >> 8, hsel = (n >> 7) & 1, jj = n & 127, bj = jj >> 6, j = jj & 63; dr = tile * 256 + bj * 128 + hsel * 64 + j; } \
            conv_item(args.in[I_WIN], NPROJ, Win, DM, kb * 64, n0, dr, F.lane); } \
        else if (kind == 3) { const int kb = r / 32, nb = r % 32; conv_item(args.in[I_WOUT], DM, Wout, DM, kb * 64, nb * 64, nb * 64 + F.lane, F.lane); } \
        else { const int g = r / NI_POOL, item = r % NI_POOL, kb = item / 8, nb = item % 8; \
            conv_item(args.in[I_POOLW] + (size_t)g * 512 * 512, 512, Wpool + (size_t)g * 512 * 512, 512, kb * 64, nb * 64, nb * 64 + F.lane, F.lane); } } while (0)
#define CONVERT_IN_TAIL(LO, N) do { if (blockIdx.x >= 32) { const int wk_ = ((int)blockIdx.x - 32) * NWAVES + F.wave, nwk_ = (F.G - 32) * NWAVES; \
        for (int it_ = wk_; it_ < (N); it_ += nwk_) CONVERT_ITEM((LO) + it_); } __syncthreads(); } while (0)

#define BUILD_SC() do { LAS float* SC_ = (LAS float*)(F.lds + 8 * 8704); \
        for (int i = F.tid; i < 5 * DM; i += NTHR) { const int r = i / DM, k = i % DM; const float cv = r < 4 ? args.in[I_C][r * DM + k] : args.in[I_CCTX][k]; SC_[i] = cv / (1.0f + expf(-cv)); } \
        __syncthreads(); } while (0)
#define GEMV_ITEM(LAYER, REM) do { const LAS float* SC_ = (const LAS float*)(F.lds + 8 * 8704); const int layer_ = (LAYER), ks_ = (REM) / 72, cb_ = (REM) % 72, col_ = cb_ * 256 + 4 * F.lane; \
        const float* wp_ = args.in[I_WMOD] + ((size_t)layer_ * DM + ks_ * 128) * MODW + col_; \
        f32x4 a0 = {0, 0, 0, 0}, a1 = a0, a2 = a0, a3 = a0, a4 = a0; \
        _Pragma("unroll 1") for (int kb_ = 0; kb_ < 128; kb_ += GV_ROWS) { f32x4 w_[GV_ROWS]; \
            _Pragma("unroll") for (int q_ = 0; q_ < GV_ROWS; ++q_) w_[q_] = __builtin_nontemporal_load((const GAS f32x4*)(wp_ + (size_t)(kb_ + q_) * MODW)); \
            __builtin_amdgcn_sched_barrier(0); \
            _Pragma("unroll") for (int g_ = 0; g_ < GV_ROWS / 8; ++g_) { \
                _Pragma("unroll") for (int q_ = 8 * g_; q_ < 8 * g_ + 8; ++q_) { const int kk = ks_ * 128 + kb_ + q_; \
                    a0 += w_[q_] * SC_[kk]; a1 += w_[q_] * SC_[DM + kk]; a2 += w_[q_] * SC_[2 * DM + kk]; a3 += w_[q_] * SC_[3 * DM + kk]; a4 += w_[q_] * SC_[4 * DM + kk]; } \
                __builtin_amdgcn_sched_barrier(0); } } \
        float* op_ = modp + ((size_t)((ks_ * 2 + layer_) * 5)) * MODW + col_; \
        *(f32x4*)(op_) = a0; *(f32x4*)(op_ + MODW) = a1; *(f32x4*)(op_ + 2 * MODW) = a2; *(f32x4*)(op_ + 3 * MODW) = a3; *(f32x4*)(op_ + 4 * MODW) = a4; } while (0)
    constexpr int GV_ROWS = 32, P2_WIN = 2500;
    constexpr int GV_P0 = KS_MOD * 24, GV_P3 = KS_MOD * 48;
    constexpr int GV_L = KS_MOD * 72, GV_P2 = GV_L / 2;

    if (IN(0)) REP(0) {
#define A3_BLOCK() \
        { \
            LAS float* WL = (LAS float*)F.lds; \
            for (int i = F.tid; i < 33 * 64; i += NTHR) WL[i] = args.in[I_FW1][i]; \
            for (int i = F.tid; i < 64 * 64; i += NTHR) { WL[2112 + i] = args.in[I_FW2][i]; WL[2112 + 4096 + i] = args.in[I_FW3][i]; } \
            __syncthreads(); \
            const int l = F.lane; \
            const float b1 = args.in[I_FB1][l], b2 = args.in[I_FB2][l], b3 = args.in[I_FB3][l], f1 = args.in[I_FREQ][l], f2 = args.in[I_FREQ][64 + l], f3 = args.in[I_FREQ][128 + l]; \
            for (int t = F.gw; t < SEQ; t += F.NGW) { \
                float z = 0.f; \
                { const float w = 6.283185307179586f * (float)t / 4096.0f; \
                  if (l == 0) z = (float)t / 4095.0f; \
                  else if (l <= 16) { const float f = 1e-4f + (float)(l - 1) * ((15.0f - 1e-4f) / 15.0f); z = cosf(f * w); } \
                  else if (l <= 32) { const float f = 1e-4f + (float)(l - 17) * ((15.0f - 1e-4f) / 15.0f); z = -sinf(f * w); } } \
                float s = b1; \
_Pragma("unroll") \
                for (int i = 0; i < 33; ++i) s += __shfl(z, i) * WL[i * 64 + l]; \
                float a = sinf(f1 * s); \
                s = b2; \
_Pragma("unroll 16") \
                for (int i = 0; i < 64; ++i) s += __shfl(a, i) * WL[2112 + i * 64 + l]; \
                a = sinf(f2 * s); \
                s = b3; \
_Pragma("unroll 16") \
                for (int i = 0; i < 64; ++i) s += __shfl(a, i) * WL[2112 + 4096 + i * 64 + l]; \
                a = sinf(f3 * s); \
                A3[t * 64 + l] = a; \
            } \
            __syncthreads(); \
        }
        const bool a3_first = (blockIdx.x & 1) == 0;
        if (a3_first) A3_BLOCK()
        BUILD_SC();
        const int pw = F.wave * F.G + (int)blockIdx.x;
        if (F.NGW > GV_L) { if (pw < GV_P0) GEMV_ITEM(0, (pw / 24) * 72 + pw % 24); } else for (int it_ = pw; it_ < GV_P0; it_ += F.NGW) GEMV_ITEM(0, (it_ / 24) * 72 + it_ % 24);
        for (int i = blockIdx.x * NTHR + F.tid; i < SEQ * 64; i += F.G * NTHR) {
            const int t = i >> 6, j = i & 63; const float pos = (float)(j < 32 ? (t >> 6) : (t & 63));
            const float inv = powf(10000.0f, -(float)(j & 31) / 32.0f); const float ang = pos * inv;
            rotc[i] = cosf(ang); rots[i] = sinf(ang);
        }
        if (F.NGW > GV_L) { if (pw >= GV_P0) for (int it_ = pw - GV_P0; it_ < CV_P0UP; it_ += F.NGW - GV_P0) CONVERT_ITEM(it_); }
        else for (int it_ = pw; it_ < CV_P0UP; it_ += F.NGW) CONVERT_ITEM(it_);
        if (!a3_first) { __syncthreads(); A3_BLOCK() }
        __syncthreads();
    }
    SEAM(0);

    if (IN(1)) REP(1) {
        for (int i = blockIdx.x * NTHR + F.tid; i < 5 * MODW / 4; i += F.G * NTHR) {
            const int e = i * 4, layer = e / (5 * MODW), r = (e / MODW) % 5, col = e % MODW;
            if (col < 3 * DM) *(f32x4*)(mod + e) = mod_from_partials(modp, args.in[I_BMOD], layer, r, col);
        }
        norm_pass(F, args.in[I_X], args.in[I_CTX], MA, nullptr, modp, args.in[I_BMOD], 0, 0, HN, F8_UP);
    }
    SEAM(1);

#define FFN_UP(f, MROWS) do { constexpr int KE = F8_UP ? DM / 2 : DM; pg8::Gemm g{KE, KE, KE}; pg8::StaticOrder S; S.init(HN, Wup + (size_t)(f) * UPSZ, (MROWS), NUP, KE, KE, F.G, (int)blockIdx.x); \
        pg8::EpiSwiglu<F8_DN != 0> E{HID, F8_DN ? DFF : DFF, F8_UP ? 1.0f / (pg8::F8S_ACT * pg8::F8S_WUP) : 1.0f}; pg8::gemm_phase<pg8::EpiSwiglu<F8_DN != 0>, pg8::StaticOrder, true, true, F8_UP != 0>(F.lds, g, S, E); } while (0)
#define FFN_DN(f, MROWS, BF32_, BL, BC, LAYER, J) do { constexpr int KE = F8_DN ? DFF / 2 : DFF; pg8::Gemm g{KE, KE, KE}; pg8::StaticOrder S; S.init(HID, Wdn + (size_t)(f) * DNSZ, (MROWS), DM, KE, KE, F.G, (int)blockIdx.x); \
        pg8::EpiResid<BF32_> E{(BL), (BC), (pg8::bf16_t*)XB, mod + ((size_t)((LAYER) * 5) * 9 + (J)) * DM, 9 * DM, nullptr, F8_DN ? 0.5f / (pg8::F8S_HID * pg8::F8S_WDN) : 0.5f}; pg8::gemm_phase<pg8::EpiResid<BF32_>, pg8::StaticOrder, true, true, F8_DN != 0>(F.lds, g, S, E); } while (0)

    if (IN(2)) REP(2) { FFN_UP(0, MA);
        const int nun_ = (MA / 256) * (NUP / 256), fi_ = nun_ % F.G, nidle_ = fi_ ? F.G - fi_ : F.G, widx_ = fi_ ? (int)blockIdx.x - fi_ : (int)blockIdx.x;
        if (widx_ >= 0) { BUILD_SC(); for (int it_ = F.wave * nidle_ + widx_; it_ < GV_P2; it_ += nidle_ * NWAVES) GEMV_ITEM(1, it_);
            for (int it_ = F.wave * nidle_ + widx_; it_ < NI_DN; it_ += nidle_ * NWAVES) CONVERT_ITEM(CV_P0UP + it_);
            for (int it_ = F.wave * nidle_ + widx_; it_ < P2_WIN; it_ += nidle_ * NWAVES) CONVERT_ITEM(CV_N0 + it_);
            __syncthreads(); }
    }
    SEAM(2);
    if (IN(3)) { FFN_DN(0, MA, true, args.in[I_X], args.in[I_CTX], 0, 2);
        LAS float* W4T = (LAS float*)F.lds;
        for (int it = (int)blockIdx.x - 32; it >= 0 && it < 512; it += F.G - 32) {
            const int tb = it >> 6, cb = it & 63, t = tb * 512 + F.tid;
            __syncthreads();
            for (int i = F.tid; i < 4096; i += NTHR) { const int k = i >> 6, c = i & 63; W4T[c * 64 + k] = args.in[I_FW4][(size_t)k * 4096 + cb * 64 + c]; }
            typedef float f32x2_ __attribute__((ext_vector_type(2)));
            f32x2_ a2[32];
#pragma unroll
            for (int q = 0; q < 16; ++q) { const f32x4 v = *(const f32x4*)(A3 + (size_t)t * 64 + 4 * q); a2[2 * q] = (f32x2_){v.x, v.y}; a2[2 * q + 1] = (f32x2_){v.z, v.w}; }
            __syncthreads();
            const float tn = (float)t / 4095.0f;
#pragma unroll 2
            for (int c = 0; c < 64; ++c) {
                f32x2_ sa = {0.f, 0.f}, sb = {0.f, 0.f};
#pragma unroll
                for (int q = 0; q < 16; ++q) { const f32x4 w = *(const LAS f32x4*)(W4T + c * 64 + 4 * q); sa += a2[2 * q] * (f32x2_){w.x, w.y}; sb += a2[2 * q + 1] * (f32x2_){w.z, w.w}; }
                const float s = (sa.x + sa.y) + (sb.x + sb.y);
                const int col = cb * 64 + c, o = col >> 11, side = (col >> 10) & 1, ch = col & 1023;
                const float mind = -3.0701134573253945f, maxd = -15.350567286626973f;
                const float delta = fabsf(mind + (float)ch * ((maxd - mind) / 1023.0f));
                const float val = s * expf(-tn * delta);
                bf16* kr = KR + ((size_t)(o * 1024 + ch)) * 8192;
                if (side == 0) kr[4096 - t] = (bf16)f2bf(val);
                else kr[t == 0 ? 0 : 4096 + t] = (bf16)f2bf(t == 0 ? 0.0f : val);
            }
        }
        __syncthreads();
        if (blockIdx.x >= 32) { constexpr int LO_ = CV_N0 + P2_WIN, N_ = CV_N1A - P2_WIN;
            const int nw_ = F.G - 32, wgi_ = (int)blockIdx.x - 32, krx_ = nw_ < 512 ? 512 % nw_ : 0, nb_ = (nw_ - krx_) * NWAVES;
            BUILD_SC();
            const int ngv_ = nb_ >= GV_P3 ? GV_P3 : 0, nb2_ = nb_ - ngv_, nng_ = krx_ * NWAVES + nb2_;
            int pre_ = 4 * nb2_, pre2_ = pre_ + nng_; if (pre2_ > N_) { pre_ = 0; pre2_ = 0; }
            constexpr int GV_ROWS = 16;
            if (wgi_ >= krx_) { const int wb_ = (wgi_ - krx_) + (nw_ - krx_) * F.wave;
                if (wb_ < ngv_) GEMV_ITEM(0, (wb_ / 48) * 72 + 24 + wb_ % 48);
                else if (pre2_ > 0) { for (int j_ = 0; j_ < 4; ++j_) CONVERT_ITEM(LO_ + (wb_ - ngv_) + j_ * nb2_); CONVERT_ITEM(LO_ + pre_ + krx_ * NWAVES + (wb_ - ngv_)); } }
            else if (pre2_ > 0) CONVERT_ITEM(LO_ + pre_ + wgi_ + krx_ * F.wave);
            if (ngv_ == 0) for (int it_ = wgi_ + nw_ * F.wave; it_ < GV_P3; it_ += nw_ * NWAVES) GEMV_ITEM(0, (it_ / 48) * 72 + 24 + it_ % 48);
            for (int it_ = pre2_ + wgi_ + nw_ * F.wave; it_ < N_; it_ += nw_ * NWAVES) CONVERT_ITEM(LO_ + it_); }
        __syncthreads();
    }
    SEAM(3);
    if (IN(4)) REP(4) {
        int i0_ = blockIdx.x * NTHR + F.tid; asm volatile("" : "+v"(i0_));
        for (int i = i0_; i < 5 * MODW / 4; i += F.G * NTHR) {
            const int e = i * 4, r = e / MODW, col = e % MODW;
            if (col >= 3 * DM) *(f32x4*)(mod + e) = mod_from_partials(modp, args.in[I_BMOD], 0, r, col);
        }
        norm_pass_h(F, XB, MA, mod, 0, 3, HN, false, modp, args.in[I_BMOD]);
    }
    SEAM(4);
    if (IN(5)) REP(5) {
        struct WinOrder {
            int G, c; const char* HN; const char* Win;
            __device__ __forceinline__ bool next(int i, pg8::Unit& u) const {
                const int L = i * G + c; const size_t ps = (size_t)256 * DM * 2;
                if (L < 1024) { pg8::tile_of(L, 64, 16, u.pm, u.pn); u.A = HN + u.pm * ps; u.B = Win + u.pn * ps; u.ty = u.pn < 4 ? 0 : (u.pn < 8 ? 1 : (u.pn < 12 ? 2 : 3)); return true; }
                if (L < 1792) { pg8::tile_of(L - 1024, 12, 64, u.pm, u.pn); u.A = Win + (size_t)(16 + u.pm) * ps; u.B = HN + u.pn * ps; u.ty = 4; return true; }
                if (L < 1824) { pg8::tile_of(L - 1792, 4, 8, u.pm, u.pn); u.A = HN + (size_t)(64 + u.pm) * ps; u.B = Win + (size_t)(4 + u.pn) * ps; u.ty = 5; return true; }
                return false;
            }
        } S{F.G, (int)blockIdx.x, (const char*)HN, (const char*)Win};
        pg8::Gemm g{DM, DM, DM};
        pg8::EpiWin E{ws, rotc, rots};
        pg8::gemm_phase<pg8::EpiWin, WinOrder, true, true>(F.lds, g, S, E);
        if (blockIdx.x >= 32) { BUILD_SC();
            const int nwg_ = F.G - 32, wk_ = F.wave * nwg_ + ((int)blockIdx.x - 32), nwk_ = nwg_ * NWAVES, ng_ = GV_L - GV_P2;
            constexpr int NV_ = NI_WOUT + CV_N1B;
#define P5_ITEM(V) do { const int v_ = (V); if (v_ < NI_WOUT) CONVERT_ITEM(CV_P0 + v_); else CONVERT_ITEM(CV_N0 + CV_N1A + (v_ - NI_WOUT)); } while (0)
            if (nwk_ > ng_) { const int pre_ = 8 * (nwk_ - ng_);
                if (wk_ < ng_) GEMV_ITEM(1, GV_P2 + wk_); else for (int j_ = 0; j_ < 8; ++j_) P5_ITEM((wk_ - ng_) + j_ * (nwk_ - ng_));
                for (int it_ = pre_ + wk_; it_ < NV_; it_ += nwk_) P5_ITEM(it_); }
            else { for (int it_ = wk_; it_ < ng_; it_ += nwk_) GEMV_ITEM(1, GV_P2 + it_); for (int it_ = wk_; it_ < NV_; it_ += nwk_) P5_ITEM(it_); }
#undef P5_ITEM
        }
        __syncthreads();
    }
    SEAM(5);

    if (IN(6)) REP(6) {
        for (int un0 = blockIdx.x; un0 < 256; un0 += F.G) {
            const int un = (F.G == 256) ? (((un0 & 7) * 4 + (un0 >> 6)) * 8 + ((un0 >> 3) & 7)) : un0;
            const int bh = un >> 3, dir = (un >> 2) & 1, es = un & 3, b = bh >> 3, h = bh & 7;
            const float lg = args.in[I_LOGD][dir * 8 + h];
            const float cdec = fexp(128.0f * lg);
            constexpr int SC_K = 128 * 272, SC_V = 128 * 80, SC_SET = SC_K + SC_V;
            f32x4 acc[2] = {(f32x4){0, 0, 0, 0}, (f32x4){0, 0, 0, 0}};
            const int g4 = F.lane >> 4, q4 = (F.lane & 15) >> 2, p4 = F.lane & 3;
            v4u kraw[2][4], vraw[2];
#define SCAN_PTRS(step_) int cidx; bool isctx; if (dir == 0) { isctx = (step_) < 2; cidx = isctx ? (step_) : (step_) - 2; } else { isctx = (step_) < 2; cidx = isctx ? 1 - (step_) : 33 - (step_); } \
                const bf16* kp; const bf16* vp; int ld; if (isctx) { kp = KVC + (size_t)(b * CTXL + cidx * 128) * 2048 + h * 128; vp = kp + 1024; ld = 2048; } else { kp = QKVG + (size_t)(b * SEQ + cidx * 128) * 4096 + 1024 + h * 128; vp = kp + 1024; ld = 4096; }
#define SCAN_FETCH(S_) do { _Pragma("unroll") for (int i = 0; i < 4; ++i) { const int id = F.tid + NTHR * i, j = id >> 4, c8 = id & 15; kraw[S_][i] = *(const GAS v4u*)(kp + (size_t)j * ld + c8 * 8); } \
                { const int j = F.tid >> 2, c8 = F.tid & 3; vraw[S_] = *(const GAS v4u*)(vp + (size_t)j * ld + es * 32 + c8 * 8); } } while (0)
            { SCAN_PTRS(0); SCAN_FETCH(0); } { SCAN_PTRS(1); SCAN_FETCH(1); }
            for (int it = 0; it < 17; ++it) {
                LDS_BARRIER();
#pragma unroll
                for (int S_ = 0; S_ < 2; ++S_) {
#pragma unroll
                    for (int i = 0; i < 4; ++i) { const int id = F.tid + NTHR * i, j = id >> 4, c8 = id & 15; const v4u raw = kraw[S_][i];
                        const float kd = fexp(lg * (float)(dir == 0 ? 127 - j : j));
                        v4u o; o.x = pk2(bflo(raw.x) * kd, bfhi(raw.x) * kd); o.y = pk2(bflo(raw.y) * kd, bfhi(raw.y) * kd); o.z = pk2(bflo(raw.z) * kd, bfhi(raw.z) * kd); o.w = pk2(bflo(raw.w) * kd, bfhi(raw.w) * kd);
                        *(LAS v4u*)(F.lds + S_ * SC_SET + j * 272 + c8 * 16) = o; }
                    { const int j = F.tid >> 2, c8 = F.tid & 3; *(LAS v4u*)(F.lds + S_ * SC_SET + SC_K + j * 80 + c8 * 16) = vraw[S_]; } }
                if (it + 1 < 17) { { SCAN_PTRS(2 * it + 2); SCAN_FETCH(0); } { SCAN_PTRS(2 * it + 3); SCAN_FETCH(1); } }
                LDS_BARRIER();
                f32x4 u[2][2];
#pragma unroll
                for (int S_ = 0; S_ < 2; ++S_) { u[S_][0] = (f32x4){0, 0, 0, 0}; u[S_][1] = (f32x4){0, 0, 0, 0};
                    LAS unsigned char* KL = F.lds + S_ * SC_SET; LAS unsigned char* VL = KL + SC_K;
#pragma unroll
                    for (int ks = 0; ks < 4; ++ks) {
                        const s16x4 a0 = __builtin_amdgcn_ds_read_tr16_b64_v4i16((LAS s16x4*)(KL + (32 * ks + 8 * g4 + q4) * 272 + (16 * F.wave + 4 * p4) * 2));
                        const s16x4 a1 = __builtin_amdgcn_ds_read_tr16_b64_v4i16((LAS s16x4*)(KL + (32 * ks + 8 * g4 + 4 + q4) * 272 + (16 * F.wave + 4 * p4) * 2));
                        bf16x8 af; af[0] = a0[0]; af[1] = a0[1]; af[2] = a0[2]; af[3] = a0[3]; af[4] = a1[0]; af[5] = a1[1]; af[6] = a1[2]; af[7] = a1[3];
#pragma unroll
                        for (int c = 0; c < 2; ++c) {
                            const s16x4 b0 = __builtin_amdgcn_ds_read_tr16_b64_v4i16((LAS s16x4*)(VL + (32 * ks + 8 * g4 + q4) * 80 + (16 * c + 4 * p4) * 2));
                            const s16x4 b1 = __builtin_amdgcn_ds_read_tr16_b64_v4i16((LAS s16x4*)(VL + (32 * ks + 8 * g4 + 4 + q4) * 80 + (16 * c + 4 * p4) * 2));
                            bf16x8 bfr; bfr[0] = b0[0]; bfr[1] = b0[1]; bfr[2] = b0[2]; bfr[3] = b0[3]; bfr[4] = b1[0]; bfr[5] = b1[1]; bfr[6] = b1[2]; bfr[7] = b1[3];
                            u[S_][c] = __builtin_amdgcn_mfma_f32_16x16x32_bf16(af, bfr, u[S_][c], 0, 0, 0);
                        }
                    } }
#pragma unroll
                for (int S_ = 0; S_ < 2; ++S_) {
                    SCAN_PTRS(2 * it + S_);
                    if (!isctx) {
                        bf16* sp = SPREV + ((size_t)((bh * 2 + dir) * 32 + cidx)) * 16384;
#pragma unroll
                        for (int c = 0; c < 2; ++c)
#pragma unroll
                            for (int r = 0; r < 4; ++r) sp[(size_t)(16 * F.wave + 4 * g4 + r) * 128 + es * 32 + 16 * c + (F.lane & 15)] = (bf16)f2bf(acc[c][r]);
                    }
                    acc[0] = acc[0] * cdec + u[S_][0]; acc[1] = acc[1] * cdec + u[S_][1];
                }
            }
            LDS_BARRIER();
        }
#undef SCAN_PTRS
#undef SCAN_FETCH
#if HY_NAIVE
        for (int ch = blockIdx.x; ch < 1024; ch += F.G) {
            LAS float* Kf = (LAS float*)F.lds;
            LAS float* U = (LAS float*)(F.lds + 32768);
            const float* cw = args.in[I_CONVW]; const float* cb = args.in[I_CONVB];
            float acc[8][4];
            for (int cv = 0; cv < 2; ++cv) {
                __syncthreads();
                for (int i = F.tid; i < 8192; i += NTHR) Kf[i] = bf2f(KR[((size_t)(cv * 1024 + ch)) * 8192 + i]);
                if (cv == 0) {
                    const float w0 = cw[ch], w1 = cw[3072 + ch], w2 = cw[6144 + ch], bb = cb[ch];
                    for (int i = F.tid; i < 16384; i += NTHR) { const int b = i >> 12, t = i & 4095; const bf16* p = PHT + (size_t)ch * 16384 + i;
                        const float pm = t > 0 ? bf2f(p[-1]) : 0.f, p0 = bf2f(p[0]), pp = t < 4095 ? bf2f(p[1]) : 0.f;
                        U[t * 4 + b] = bb + pm * w0 + p0 * w1 + pp * w2; }
                } else {
                    const int c1 = 1024 + ch; const float w0 = cw[c1], w1 = cw[3072 + c1], w2 = cw[6144 + c1], bb = cb[c1], hb = args.in[I_HYB][ch];
#pragma unroll
                    for (int i = 0; i < 8; ++i)
#pragma unroll
                        for (int b = 0; b < 4; ++b) { const int t = F.tid + NTHR * i; const bf16* p = PHT + (size_t)c1 * 16384 + b * 4096 + t;
                            const float pm = t > 0 ? bf2f(p[-1]) : 0.f, p0 = bf2f(p[0]), pp = t < 4095 ? bf2f(p[1]) : 0.f;
                            const float x1 = bb + pm * w0 + p0 * w1 + pp * w2;
                            acc[i][b] = x1 * (acc[i][b] + hb * U[t * 4 + b]); }
                    __syncthreads();
#pragma unroll
                    for (int i = 0; i < 8; ++i)
#pragma unroll
                        for (int b = 0; b < 4; ++b) U[(F.tid + NTHR * i) * 4 + b] = acc[i][b];
                }
                __syncthreads();
                float a[8][4];
#pragma unroll
                for (int i = 0; i < 8; ++i)
#pragma unroll
                    for (int b = 0; b < 4; ++b) a[i][b] = 0.f;
                for (int s = 0; s < 4096; ++s) {
                    const f32x4 u = *(const LAS f32x4*)(U + s * 4);
#pragma unroll
                    for (int i = 0; i < 8; ++i) { const float kv = Kf[4096 - (F.tid + NTHR * i) + s]; a[i][0] += kv * u.x; a[i][1] += kv * u.y; a[i][2] += kv * u.z; a[i][3] += kv * u.w; }
                }
#pragma unroll
                for (int i = 0; i < 8; ++i)
#pragma unroll
                    for (int b = 0; b < 4; ++b) acc[i][b] = a[i][b];
            }
            { const int c2 = 2048 + ch; const float w0 = cw[c2], w1 = cw[3072 + c2], w2 = cw[6144 + c2], bb = cb[c2], hb = args.in[I_HYB][1024 + ch];
#pragma unroll
              for (int i = 0; i < 8; ++i)
#pragma unroll
                  for (int b = 0; b < 4; ++b) { const int t = F.tid + NTHR * i; const bf16* p = PHT + (size_t)c2 * 16384 + b * 4096 + t;
                      const float pm = t > 0 ? bf2f(p[-1]) : 0.f, p0 = bf2f(p[0]), pp = t < 4095 ? bf2f(p[1]) : 0.f;
                      const float x2 = bb + pm * w0 + p0 * w1 + pp * w2;
                      YHT[(size_t)ch * 16384 + b * 4096 + t] = (bf16)f2bf(x2 * (acc[i][b] + hb * U[t * 4 + b])); } }
            __syncthreads();
        }
#else
        {
            constexpr int HY_CP = 16448, HY_U = 4 * HY_CP, HY_UB = 4608 * 2, HY_X = HY_U + 4 * HY_UB;
            const float* cw = args.in[I_CONVW]; const float* cb = args.in[I_CONVB];
            const int l15 = F.lane & 15, g4 = F.lane >> 4, tau0 = 2 * F.wave;
            const int sg = (-l15) & 3, ci4 = (l15 + 3) >> 2;
            const int mlo = -(8 * tau0 + 8);
            const unsigned a_base = (unsigned)(sg * HY_CP + 2 * (4096 + 16 + 32 * mlo + 8 * g4 - 4 * ci4));
            const unsigned b_base = (unsigned)(HY_U + 2 * (256 + 256 * tau0 + 16 * l15 + 32 * mlo + 8 * g4));
            v4u tp[3]; v4u ra[4], rb[4]; unsigned ral[4], rar[4], rbl[4], rbr[4]; float wa[4], wb[4], hb0 = 0.f, hb1 = 0.f;
#define HY_PF_TAPS(KRP) do { _Pragma("unroll") for (int i_ = 0; i_ < 3; ++i_) { const int c_ = F.tid + NTHR * i_, x0_ = 8 * c_ - 16; tp[i_] = (v4u){0u, 0u, 0u, 0u}; \
                if (c_ < 1028 && x0_ >= 0 && x0_ < 8192) tp[i_] = *(const GAS v4u*)((KRP) + x0_); } } while (0)
#define HY_WR_TAPS() do { _Pragma("unroll") for (int i_ = 0; i_ < 3; ++i_) { const int c_ = F.tid + NTHR * i_; if (c_ < 1028) *(LAS v4u*)(F.lds + c_ * 16) = tp[i_]; } } while (0)
#define HY_PF_ROW(R_, RL_, RR_, W_, CC) do { const unsigned short* prow_ = (const unsigned short*)(PHT + (size_t)(CC) * 16384); W_[0] = cw[(CC)]; W_[1] = cw[3072 + (CC)]; W_[2] = cw[6144 + (CC)]; W_[3] = cb[(CC)]; \
                _Pragma("unroll") for (int it = 0; it < 4; ++it) { const int id = F.tid + NTHR * it, b = id >> 9, t0 = (id & 511) * 8; const unsigned short* p = prow_ + b * 4096 + t0; \
                    R_[it] = *(const GAS v4u*)p; RL_[it] = t0 > 0 ? (unsigned)p[-1] : 0u; RR_[it] = t0 < 4088 ? (unsigned)p[8] : 0u; } } while (0)
#define HY_WR_ROW(R_, RL_, RR_, W_, TO_U) do { const float w0 = W_[0], w1 = W_[1], w2 = W_[2], bb = W_[3]; \
                _Pragma("unroll") for (int it = 0; it < 4; ++it) { const int id = F.tid + NTHR * it, b = id >> 9, t0 = (id & 511) * 8; const v4u raw = R_[it]; \
                    const float x[10] = {bf2f((unsigned short)RL_[it]), bflo(raw.x), bfhi(raw.x), bflo(raw.y), bfhi(raw.y), bflo(raw.z), bfhi(raw.z), bflo(raw.w), bfhi(raw.w), bf2f((unsigned short)RR_[it])}; \
                    float o[8]; _Pragma("unroll") for (int e = 0; e < 8; ++e) o[e] = bb + x[e] * w0 + x[e + 1] * w1 + x[e + 2] * w2; \
                    v4u ov; ov.x = pk2(o[0], o[1]); ov.y = pk2(o[2], o[3]); ov.z = pk2(o[4], o[5]); ov.w = pk2(o[6], o[7]); \
                    if (TO_U) *(LAS v4u*)(F.lds + HY_U + b * HY_UB + (256 + t0) * 2) = ov; else *(LAS v4u*)(F.lds + HY_X + (b * 4096 + t0) * 2) = ov; } } while (0)
#define HY_COPIES() do { for (int w = F.tid; w < 2056; w += NTHR) { \
                const unsigned long long lo = *(const LAS unsigned long long*)(F.lds + w * 8), hi = (w < 2055) ? *(const LAS unsigned long long*)(F.lds + w * 8 + 8) : 0ull; \
                _Pragma("unroll") for (int sgm = 1; sgm < 4; ++sgm) *(LAS unsigned long long*)(F.lds + sgm * HY_CP + w * 8) = (lo >> (16 * sgm)) | (hi << (64 - 16 * sgm)); } } while (0)
#define HY_EPI(CV, CH, HB) do { const float hb = (HB); \
                _Pragma("unroll") for (int j = 0; j < 2; ++j) _Pragma("unroll") for (int b = 0; b < 4; ++b) { \
                    const int t = 256 * (tau0 + j) + 16 * l15 + 4 * g4; \
                    const v2u uv = *(const LAS v2u*)(F.lds + HY_U + b * HY_UB + (256 + t) * 2), xv = *(const LAS v2u*)(F.lds + HY_X + (b * 4096 + t) * 2); \
                    const float o0 = bflo(xv.x) * (acc[j][b][0] + hb * bflo(uv.x)), o1 = bfhi(xv.x) * (acc[j][b][1] + hb * bfhi(uv.x)); \
                    const float o2 = bflo(xv.y) * (acc[j][b][2] + hb * bflo(uv.y)), o3 = bfhi(xv.y) * (acc[j][b][3] + hb * bfhi(uv.y)); \
                    v2u ov; ov.x = pk2(o0, o1); ov.y = pk2(o2, o3); \
                    if ((CV) == 0) *(LAS v2u*)(F.lds + HY_U + b * HY_UB + (256 + t) * 2) = ov; \
                    else *(GAS v2u*)(YHT + (size_t)(CH) * 16384 + b * 4096 + t) = ov; } } while (0)
#define HY_LOAD(A0_, A1_, B_, aa_, ba_) do { const s16x4 a00_ = *(const volatile LAS s16x4*)(F.lds + (aa_)), a01_ = *(const volatile LAS s16x4*)(F.lds + (aa_) + 8), a10_ = *(const volatile LAS s16x4*)(F.lds + (aa_) - 512), a11_ = *(const volatile LAS s16x4*)(F.lds + (aa_) - 504);     \
                A0_ = __builtin_shufflevector(a00_, a01_, 0, 1, 2, 3, 4, 5, 6, 7); A1_ = __builtin_shufflevector(a10_, a11_, 0, 1, 2, 3, 4, 5, 6, 7); \
                _Pragma("unroll") for (int b = 0; b < 4; ++b) B_[b] = *(const LAS bf16x8*)(F.lds + (ba_) + b * HY_UB); } while (0)
#define HY_MMA(A0_, A1_, B_) do { _Pragma("unroll") for (int b = 0; b < 4; ++b) { acc[0][b] = __builtin_amdgcn_mfma_f32_16x16x32_bf16(A0_, B_[b], acc[0][b], 0, 0, 0); acc[1][b] = __builtin_amdgcn_mfma_f32_16x16x32_bf16(A1_, B_[b], acc[1][b], 0, 0, 0); } } while (0)
#define HY_LOOP() do { _Pragma("unroll") for (int j = 0; j < 2; ++j) _Pragma("unroll") for (int b = 0; b < 4; ++b) acc[j][b] = (f32x4){0.f, 0.f, 0.f, 0.f}; \
                bf16x8 XA0, XA1, XB[4], YA0, YA1, YB[4]; unsigned aa = a_base, ba = b_base; \
                HY_LOAD(XA0, XA1, XB, aa, ba); \
                for (int m = 0; m < 136; m += 2) { \
                    HY_LOAD(YA0, YA1, YB, aa + 64, ba + 64); __builtin_amdgcn_sched_barrier(0); \
                    HY_MMA(XA0, XA1, XB); __builtin_amdgcn_sched_barrier(0); \
                    if (m + 2 < 136) HY_LOAD(XA0, XA1, XB, aa + 128, ba + 128); \
                    __builtin_amdgcn_sched_barrier(0); \
                    HY_MMA(YA0, YA1, YB); __builtin_amdgcn_sched_barrier(0); \
                    aa += 128; ba += 128; } } while (0)
            f32x4 acc[2][4];
            int ch = blockIdx.x, chp = -1;
            if (ch < 1024) { HY_PF_TAPS(KR + (size_t)ch * 8192); HY_PF_ROW(ra, ral, rar, wa, ch); HY_PF_ROW(rb, rbl, rbr, wb, 1024 + ch); }
            for (; ch < 1024; ch += F.G) {
                LDS_BARRIER();
                if (chp >= 0) HY_EPI(1, chp, hb1);
                HY_WR_TAPS();
                LDS_BARRIER();
                if (F.tid < 256) { const int b = F.tid >> 6, q = F.tid & 63; const int off = (q < 32 ? q * 8 : 4352 + (q - 32) * 8); *(LAS v4u*)(F.lds + HY_U + b * HY_UB + off * 2) = (v4u){0u, 0u, 0u, 0u}; }
                HY_WR_ROW(ra, ral, rar, wa, true); HY_WR_ROW(rb, rbl, rbr, wb, false);
                HY_COPIES();
                hb0 = args.in[I_HYB][ch]; HY_PF_TAPS(KR + (size_t)(1024 + ch) * 8192); HY_PF_ROW(ra, ral, rar, wa, 2048 + ch);
                LDS_BARRIER();
                HY_LOOP();
                LDS_BARRIER();
                HY_EPI(0, ch, hb0);
                HY_WR_TAPS();
                LDS_BARRIER();
                HY_WR_ROW(ra, ral, rar, wa, false);
                HY_COPIES();
                hb1 = args.in[I_HYB][1024 + ch];
                if (ch + F.G < 1024) { const int chn = ch + F.G; HY_PF_TAPS(KR + (size_t)chn * 8192); HY_PF_ROW(ra, ral, rar, wa, chn); HY_PF_ROW(rb, rbl, rbr, wb, 1024 + chn); }
                LDS_BARRIER();
                HY_LOOP();
                chp = ch;
            }
            LDS_BARRIER();
            if (chp >= 0) HY_EPI(1, chp, hb1);
            LDS_BARRIER();
#undef HY_PF_TAPS
#undef HY_WR_TAPS
#undef HY_PF_ROW
#undef HY_WR_ROW
#undef HY_COPIES
#undef HY_EPI
#undef HY_LOAD
#undef HY_MMA
#undef HY_LOOP
        }
#endif
    }
    SEAM(6);

    if (IN(7)) REP(7) {
        constexpr int PT = 272;
        LAS unsigned char* QL = F.lds; LAS unsigned char* KL = F.lds + 128 * PT; LAS unsigned char* VL = F.lds + 2 * 128 * PT; LAS unsigned char* SL = F.lds + 3 * 128 * PT;
        const int g4 = F.lane >> 4, q4 = (F.lane & 15) >> 2, p4 = F.lane & 3, l15 = F.lane & 15, w = F.wave;
        v4u pq[4], pk[4], pv[4], ps[4], pb[4];
#define RO_FETCH_QK(UN) do { const int bh_ = (UN) >> 5, c_ = (UN) & 31; const bf16* qp_ = QKVG + ((size_t)(bh_ >> 3) * SEQ + c_ * 128) * 4096 + (bh_ & 7) * 128; \
            _Pragma("unroll") for (int i = 0; i < 4; ++i) { const int id = F.tid + NTHR * i, j = id >> 4, c8 = id & 15; \
                pq[i] = *(const GAS v4u*)(qp_ + (size_t)j * 4096 + c8 * 8); pk[i] = *(const GAS v4u*)(qp_ + (size_t)j * 4096 + 1024 + c8 * 8); } } while (0)
        if ((int)blockIdx.x < 1024) RO_FETCH_QK((int)blockIdx.x);
        for (int un = blockIdx.x; un < 1024; un += F.G) {
            const int bh = un >> 5, c = un & 31, b = bh >> 3, h = bh & 7;
            const float lgf = args.in[I_LOGD][h], lgb = args.in[I_LOGD][8 + h];
            const size_t row0 = (size_t)b * SEQ + c * 128;
            const bf16* qp = QKVG + row0 * 4096 + h * 128;
            LDS_BARRIER();
#pragma unroll
            for (int i = 0; i < 4; ++i) { const int id = F.tid + NTHR * i, j = id >> 4, c8 = id & 15; *(LAS v4u*)(QL + j * PT + c8 * 16) = pq[i]; *(LAS v4u*)(KL + j * PT + c8 * 16) = pk[i]; }
#pragma unroll
            for (int i = 0; i < 4; ++i) { const int id = F.tid + NTHR * i, j = id >> 4, c8 = id & 15;
                ps[i] = *(const GAS v4u*)(SPREV + ((size_t)((bh * 2 + 0) * 32 + c)) * 16384 + j * 128 + c8 * 8);
                pv[i] = *(const GAS v4u*)(qp + (size_t)j * 4096 + 2048 + c8 * 8); }
            if (un + F.G < 1024) RO_FETCH_QK(un + F.G);
            LDS_BARRIER();
            bf16x8 qf[4];
#pragma unroll
            for (int ks = 0; ks < 4; ++ks) qf[ks] = *(const LAS bf16x8*)(QL + (16 * w + l15) * PT + (32 * ks + 8 * g4) * 2);
            f32x4 sc[8];
#pragma unroll
            for (int jb = 0; jb < 8; ++jb) { sc[jb] = (f32x4){0, 0, 0, 0};
#pragma unroll
                for (int ks = 0; ks < 4; ++ks) { const bf16x8 kf = *(const LAS bf16x8*)(KL + (16 * jb + l15) * PT + (32 * ks + 8 * g4) * 2); sc[jb] = __builtin_amdgcn_mfma_f32_16x16x32_bf16(qf[ks], kf, sc[jb], 0, 0, 0); } }
#pragma unroll
            for (int i = 0; i < 4; ++i) { const int id = F.tid + NTHR * i, j = id >> 4, c8 = id & 15; *(LAS v4u*)(SL + j * PT + c8 * 16) = ps[i]; *(LAS v4u*)(VL + j * PT + c8 * 16) = pv[i]; }
            LDS_BARRIER();
            { int dbase = 16 * w + 4 * g4 - l15; asm volatile("" : "+v"(dbase));
#pragma unroll
              for (int jb = 0; jb < 8; ++jb)
#pragma unroll
                  for (int r = 0; r < 4; ++r) { const int i = 16 * w + 4 * g4 + r, j = 16 * jb + l15; const int df = dbase + r - 16 * jb;
                      const float dv = df > 0 ? fexp(lgf * (float)df) : (df < 0 ? fexp(lgb * (float)(-df)) : 2.0f);
                      *(LAS unsigned short*)(KL + i * PT + j * 2) = (unsigned short)f2bf(sc[jb][r] * dv); } }
#pragma unroll
            for (int i = 0; i < 4; ++i) { const int id = F.tid + NTHR * i, j = id >> 4, c8 = id & 15; pb[i] = *(const GAS v4u*)(SPREV + ((size_t)((bh * 2 + 1) * 32 + c)) * 16384 + j * 128 + c8 * 8); }
            f32x4 acc[8];
#pragma unroll
            for (int eb = 0; eb < 8; ++eb) { acc[eb] = (f32x4){0, 0, 0, 0};
#pragma unroll
                for (int ks = 0; ks < 4; ++ks) {
                    const s16x4 b0 = __builtin_amdgcn_ds_read_tr16_b64_v4i16((LAS s16x4*)(SL + (32 * ks + 8 * g4 + q4) * PT + (16 * eb + 4 * p4) * 2));
                    const s16x4 b1 = __builtin_amdgcn_ds_read_tr16_b64_v4i16((LAS s16x4*)(SL + (32 * ks + 8 * g4 + 4 + q4) * PT + (16 * eb + 4 * p4) * 2));
                    bf16x8 bfr; bfr[0] = b0[0]; bfr[1] = b0[1]; bfr[2] = b0[2]; bfr[3] = b0[3]; bfr[4] = b1[0]; bfr[5] = b1[1]; bfr[6] = b1[2]; bfr[7] = b1[3];
                    acc[eb] = __builtin_amdgcn_mfma_f32_16x16x32_bf16(qf[ks], bfr, acc[eb], 0, 0, 0); } }
            LDS_BARRIER();
#pragma unroll
            for (int i = 0; i < 4; ++i) { const int id = F.tid + NTHR * i, j = id >> 4, c8 = id & 15; *(LAS v4u*)(SL + j * PT + c8 * 16) = pb[i]; }
            float sfr[4], sbr[4];
#pragma unroll
            for (int r = 0; r < 4; ++r) { const int i = 16 * w + 4 * g4 + r; sfr[r] = fexp(lgf * (float)(i + 1)); sbr[r] = fexp(lgb * (float)(128 - i)); }
#pragma unroll
            for (int eb = 0; eb < 8; ++eb)
#pragma unroll
                for (int r = 0; r < 4; ++r) acc[eb][r] *= sfr[r] / sbr[r];
            LDS_BARRIER();
#pragma unroll
            for (int eb = 0; eb < 8; ++eb)
#pragma unroll
                for (int ks = 0; ks < 4; ++ks) {
                    const s16x4 b0 = __builtin_amdgcn_ds_read_tr16_b64_v4i16((LAS s16x4*)(SL + (32 * ks + 8 * g4 + q4) * PT + (16 * eb + 4 * p4) * 2));
                    const s16x4 b1 = __builtin_amdgcn_ds_read_tr16_b64_v4i16((LAS s16x4*)(SL + (32 * ks + 8 * g4 + 4 + q4) * PT + (16 * eb + 4 * p4) * 2));
                    bf16x8 bfr; bfr[0] = b0[0]; bfr[1] = b0[1]; bfr[2] = b0[2]; bfr[3] = b0[3]; bfr[4] = b1[0]; bfr[5] = b1[1]; bfr[6] = b1[2]; bfr[7] = b1[3];
                    acc[eb] = __builtin_amdgcn_mfma_f32_16x16x32_bf16(qf[ks], bfr, acc[eb], 0, 0, 0); }
#pragma unroll
            for (int eb = 0; eb < 8; ++eb)
#pragma unroll
                for (int r = 0; r < 4; ++r) acc[eb][r] *= sbr[r];
            bf16x8 pf[4];
#pragma unroll
            for (int ks = 0; ks < 4; ++ks) pf[ks] = *(const LAS bf16x8*)(KL + (16 * w + l15) * PT + (32 * ks + 8 * g4) * 2);
#pragma unroll
            for (int eb = 0; eb < 8; ++eb)
#pragma unroll
                for (int ks = 0; ks < 4; ++ks) {
                    const s16x4 b0 = __builtin_amdgcn_ds_read_tr16_b64_v4i16((LAS s16x4*)(VL + (32 * ks + 8 * g4 + q4) * PT + (16 * eb + 4 * p4) * 2));
                    const s16x4 b1 = __builtin_amdgcn_ds_read_tr16_b64_v4i16((LAS s16x4*)(VL + (32 * ks + 8 * g4 + 4 + q4) * PT + (16 * eb + 4 * p4) * 2));
                    bf16x8 bfr; bfr[0] = b0[0]; bfr[1] = b0[1]; bfr[2] = b0[2]; bfr[3] = b0[3]; bfr[4] = b1[0]; bfr[5] = b1[1]; bfr[6] = b1[2]; bfr[7] = b1[3];
                    acc[eb] = __builtin_amdgcn_mfma_f32_16x16x32_bf16(pf[ks], bfr, acc[eb], 0, 0, 0); }
#pragma unroll
            for (int r = 0; r < 4; ++r) {
                float s2 = 0.f;
#pragma unroll
                for (int eb = 0; eb < 8; ++eb) s2 += acc[eb][r] * acc[eb][r];
                s2 += __shfl_xor(s2, 1); s2 += __shfl_xor(s2, 2); s2 += __shfl_xor(s2, 4); s2 += __shfl_xor(s2, 8);
                const float rstd = 1.0f / sqrtf(s2 * (1.0f / 128.0f) + 1e-6f);
                const size_t row = row0 + 16 * w + 4 * g4 + r;
#pragma unroll
                for (int eb = 0; eb < 8; ++eb) { const int e = 16 * eb + l15; const float gv = bf2f(QKVG[row * 4096 + 3072 + h * 128 + e]);
                    A2[row * DM + h * 128 + e] = (bf16)f2bf(acc[eb][r] * rstd * gv); }
            }
        }
#undef RO_FETCH_QK
        __syncthreads();
        constexpr int TSZ = 64 * 72;
        LAS unsigned short* T = (LAS unsigned short*)F.lds;
        for (int it0 = blockIdx.x; it0 < 16 * 256; it0 += 8 * F.G) {
            v4u raw[8];
#pragma unroll
            for (int i = 0; i < 8; ++i) { const int it = it0 + i * F.G; if (it < 16 * 256) { const int cb = it >> 8, tb = it & 255, chl = F.tid >> 3, tk = F.tid & 7;
                raw[i] = *(const GAS v4u*)(YHT + (size_t)(cb * 64 + chl) * 16384 + tb * 64 + tk * 8); } }
            __syncthreads();
#pragma unroll
            for (int i = 0; i < 8; ++i) { const int it = it0 + i * F.G; if (it < 16 * 256) { const int chl = F.tid >> 3, tk = F.tid & 7; LAS unsigned short* Ti = T + i * TSZ;
                const unsigned wv[4] = {raw[i].x, raw[i].y, raw[i].z, raw[i].w};
#pragma unroll
                for (int x = 0; x < 4; ++x) { Ti[(tk * 8 + 2 * x) * 72 + chl] = (unsigned short)(wv[x] & 0xffffu); Ti[(tk * 8 + 2 * x + 1) * 72 + chl] = (unsigned short)(wv[x] >> 16); } } }
            __syncthreads();
#pragma unroll
            for (int i = 0; i < 8; ++i) { const int it = it0 + i * F.G; if (it < 16 * 256) { const int cb = it >> 8, tb = it & 255, tk = F.tid >> 3, ck = F.tid & 7;
                *(GAS v4u*)(A2 + (size_t)(tb * 64 + tk) * DM + 1024 + cb * 64 + ck * 8) = *(const LAS v4u*)(T + i * TSZ + tk * 72 + ck * 8); } }
        }
        __syncthreads();
    }
    SEAM(7);
    if (IN(8)) { pg8::Gemm g{DM, DM, DM}; pg8::StaticOrder S; S.init(A2, Wout, ML, DM, DM, DM, F.G, (int)blockIdx.x);
        pg8::EpiResid<false> E{XB, XB, (pg8::bf16_t*)XB, mod + ((size_t)(0 * 5) * 9 + 5) * DM, 9 * DM, nullptr, 1.0f}; pg8::gemm_phase<pg8::EpiResid<false>, pg8::StaticOrder, true, true>(F.lds, g, S, E); }
    SEAM(8);
    if (IN(9)) {
        for (int i = blockIdx.x * NTHR + F.tid; i < 5 * MODW / 4; i += F.G * NTHR) {
            const int e = i * 4, r = e / MODW, col = e % MODW;
            *(f32x4*)(mod + 5 * MODW + e) = mod_from_partials(modp, args.in[I_BMOD], 1, r, col);
        }
        norm_pass_h(F, XB, ML, mod, 0, 6, HN, F8_UP);
    }
    SEAM(9);
    if (IN(10)) REP(10) FFN_UP(1, ML);
    SEAM(10);
    if (IN(11)) FFN_DN(1, ML, false, XB, XB, 0, 8);
    SEAM(11);
    if (IN(12)) norm_pass_h(F, XB, ML, mod, 1, 0, HN, F8_UP);
    SEAM(12);
    if (IN(13)) FFN_UP(2, ML);
    SEAM(13);
    if (IN(14)) FFN_DN(2, ML, false, XB, XB, 1, 2);
    SEAM(14);
    if (IN(15)) norm_pass_h(F, XB, ML, mod, 1, 3, HN, false);
    SEAM(15);
    if (IN(16)) REP(16) {
        constexpr int PR = 2080;
        for (int un0 = blockIdx.x; un0 < 512; un0 += F.G) {
            int un = un0;
            if (F.G == 256) { const int w = un0 & 255, r = un0 >> 8, x = w & 7, y = w >> 3, j = x + 8 * (y >> 2); un = (2 * r + (j >> 5)) * 128 + 4 * (j & 31) + (y & 3); }
            const int b = un >> 7, cb = un & 127, hw = 1 << (cb >> 5);
            const bf16* src = HN + (size_t)b * SEQ * DM + cb * 16;
            bf16* dst = DD + (size_t)b * SEQ * DM + cb * 16;
            v4u h[16];
#pragma unroll
            for (int j = 0; j < 16; ++j) { const int idx = F.tid + NTHR * j, token = idx >> 1, half = idx & 1; h[j] = *(const GAS v4u*)(src + (size_t)token * DM + half * 8); }
            __syncthreads();
#pragma unroll
            for (int j = 0; j < 16; ++j) { const int idx = F.tid + NTHR * j, token = idx >> 1, half = idx & 1; *(LAS v4u*)(F.lds + (token >> 6) * PR + (token & 63) * 32 + half * 16) = h[j]; }
            __syncthreads();
#pragma unroll 1
            for (int pass = 0; pass < 2; ++pass) {
                const int line = F.tid >> 3, cp = F.tid & 7;
                const int base = (pass == 0 ? line * PR : line * 32) + cp * 4, stride = pass == 0 ? 32 : PR;
                int hwv = hw; asm volatile("" : "+s"(hwv));
                float s0 = 0.f, s1 = 0.f;
                for (int q = 0; q < hw; ++q) { const unsigned w = *(const LAS unsigned*)(F.lds + base + q * stride); s0 += bflo(w); s1 += bfhi(w); }
                unsigned o[64];
#pragma unroll
                for (int p = 0; p < 64; ++p) {
                    const int lo_ = p - hwv < 0 ? 0 : p - hwv, hi_ = p + hwv - 1 > 63 ? 63 : p + hwv - 1; const float inv = __builtin_amdgcn_rcpf((float)(hi_ - lo_ + 1));
                    o[p] = pk2(s0 * inv, s1 * inv);
                    const int pi = p + hw > 63 ? 63 : p + hw, po = p - hw < 0 ? 0 : p - hw; const float fi = p + hw <= 63 ? 1.0f : 0.0f, fo = p - hw >= 0 ? 1.0f : 0.0f;
                    const unsigned wi = *(const LAS unsigned*)(F.lds + base + pi * stride), wo = *(const LAS unsigned*)(F.lds + base + po * stride);
                    s0 += fi * bflo(wi) - fo * bflo(wo); s1 += fi * bfhi(wi) - fo * bfhi(wo);
                    if ((p & 7) == 7) __builtin_amdgcn_sched_barrier(0);
                }
#pragma unroll
                for (int p = 0; p < 64; ++p) *(LAS unsigned*)(F.lds + base + p * stride) = o[p];
                __syncthreads();
            }
#pragma unroll
            for (int j = 0; j < 16; ++j) { const int idx = F.tid + NTHR * j, token = idx >> 1, half = idx & 1;
                const v4u m = *(const LAS v4u*)(F.lds + (token >> 6) * PR + (token & 63) * 32 + half * 16);
                v4u ov; ov.x = pk2(bflo(m.x) - bflo(h[j].x), bfhi(m.x) - bfhi(h[j].x)); ov.y = pk2(bflo(m.y) - bflo(h[j].y), bfhi(m.y) - bfhi(h[j].y));
                ov.z = pk2(bflo(m.z) - bflo(h[j].z), bfhi(m.z) - bfhi(h[j].z)); ov.w = pk2(bflo(m.w) - bflo(h[j].w), bfhi(m.w) - bfhi(h[j].w));
                *(GAS v4u*)(dst + (size_t)token * DM + half * 8) = ov; }
        }
        __syncthreads();
    }
    SEAM(16);
    if (IN(18)) {
        struct PoolOrder {
            int G, c; const char* D; const char* W;
            __device__ __forceinline__ bool next(int i, pg8::Unit& u) const {
                const int L = i * G + c; if (L >= 512) return false;
                pg8::tile_of(L, 64, 8, u.pm, u.pn); const int g = u.pn >> 1; u.ty = 0;
                u.A = D + ((size_t)u.pm * 256 * DM + g * 512) * 2; u.B = W + ((size_t)g * 512 * 512 + (size_t)(u.pn & 1) * 256 * 512) * 2; return true;
            }
        } S{F.G, (int)blockIdx.x, (const char*)DD, (const char*)Wpool};
        pg8::Gemm g{512, DM, 512};
        pg8::EpiResid<false> E{XB, XB, (pg8::bf16_t*)XB, mod + ((size_t)(1 * 5) * 9 + 5) * DM, 9 * DM, args.in[I_POOLS], 1.0f};
        pg8::gemm_phase<pg8::EpiResid<false>, PoolOrder, true, true>(F.lds, g, S, E);
    }
    SEAM(18);
    if (IN(19)) norm_pass_h(F, XB, ML, mod, 1, 6, HN, F8_UP);
    SEAM(19);
    if (IN(20)) FFN_UP(3, ML);
    SEAM(20);
    if (IN(21)) FFN_DN(3, ML, false, XB, XB, 1, 8);
    SEAM(21);
    if (IN(22)) {
        { int row = F.gw; v4u vn[4];
          if (row < ML) {
#pragma unroll
              for (int q = 0; q < 4; ++q) vn[q] = *(const GAS v4u*)(XB + (size_t)row * DM + 8 * F.lane + 512 * q); }
          while (row < ML) {
            v4u v[4]; float s2 = 0.f;
#pragma unroll
            for (int q = 0; q < 4; ++q) v[q] = vn[q];
            const int rn = row + F.NGW;
            if (rn < ML) {
#pragma unroll
                for (int q = 0; q < 4; ++q) vn[q] = *(const GAS v4u*)(XB + (size_t)rn * DM + 8 * F.lane + 512 * q); }
            f32x4 x0[4], x1[4];
#pragma unroll
            for (int q = 0; q < 4; ++q) { x0[q] = (f32x4){bflo(v[q].x), bfhi(v[q].x), bflo(v[q].y), bfhi(v[q].y)}; x1[q] = (f32x4){bflo(v[q].z), bfhi(v[q].z), bflo(v[q].w), bfhi(v[q].w)};
                s2 += ((x0[q].x * x0[q].x + x0[q].y * x0[q].y) + (x0[q].z * x0[q].z + x0[q].w * x0[q].w)) + ((x1[q].x * x1[q].x + x1[q].y * x1[q].y) + (x1[q].z * x1[q].z + x1[q].w * x1[q].w)); }
            const float rstd = 1.0f / sqrtf(wave_sum(s2) * (1.0f / DM) + 1e-6f);
#pragma unroll
            for (int q = 0; q < 4; ++q) { const int col = 8 * F.lane + 512 * q;
                *(GAS f32x4*)(args.out + (size_t)row * DM + col) = x0[q] * rstd * *(const f32x4*)(args.in[I_FGAIN] + col);
                *(GAS f32x4*)(args.out + (size_t)row * DM + col + 4) = x1[q] * rstd * *(const f32x4*)(args.in[I_FGAIN] + col + 4); }
            row = rn;
          } }
    }
#undef IN
#undef SEAM
}

extern "C" void kernel_launch(void* const* d_in, const int* in_sizes, int n_in, void* d_out, int out_size, void* d_ws, size_t ws_size, hipStream_t stream) {
    static int grid = 0;
    if (grid == 0) {
        if (n_in != 29 || in_sizes[0] != ML * DM || out_size != ML * DM || ws_size < WS_END) { fprintf(stderr, "kernel_launch: unexpected shapes (n_in %d, ws %zu)\n", n_in, ws_size); grid = -1; return; }
        int dev = 0, cus = 0, per_cu = 0;
        if (hipGetDevice(&dev) != hipSuccess || hipDeviceGetAttribute(&cus, hipDeviceAttributeMultiprocessorCount, dev) != hipSuccess) { grid = -1; return; }
        if (hipFuncSetAttribute((const void*)mk_fwd, hipFuncAttributeMaxDynamicSharedMemorySize, LDS_BYTES) != hipSuccess) { grid = -1; return; }
        if (hipOccupancyMaxActiveBlocksPerMultiprocessor(&per_cu, (const void*)mk_fwd, NTHR, LDS_BYTES) != hipSuccess || per_cu < 1) { fprintf(stderr, "kernel_launch: occupancy query says %d\n", per_cu); }
        (void)hipGetLastError();
        grid = cus;
    }
    if (grid < 0) return;
    if (hipMemsetAsync((char*)d_ws + WS_CTL, 0, CTL_ZERO_BYTES, stream) != hipSuccess) return;
    Args a{};
    for (int i = 0; i < 29; ++i) a.in[i] = (const float*)d_in[i];
    a.out = (float*)d_out; a.ws = (unsigned char*)d_ws;
#if MK_PER_PHASE_LAUNCH
    for (int ph = 0; ph < NPHASE; ++ph) { a.ph_lo = ph; a.ph_hi = ph + 1; hipLaunchKernelGGL(mk_fwd, dim3(grid), dim3(NTHR), LDS_BYTES, stream, a); }
#else
    a.ph_lo = 0; a.ph_hi = NPHASE;
    hipLaunchKernelGGL(mk_fwd, dim3(grid), dim3(NTHR), LDS_BYTES, stream, a);
#endif
}
```

```cpp
#include <hip/hip_runtime.h>
#include <cstdio>
#include <cstdint>

#ifndef MK_PER_PHASE_LAUNCH
#define MK_PER_PHASE_LAUNCH 0
#endif
#ifndef F8_UP
#define F8_UP 1
#endif
#ifndef F8_DN
#define F8_DN 1
#endif
#ifndef DUP_PHASE
#define DUP_PHASE -1
#endif
#ifndef HY_NAIVE
#define HY_NAIVE 0
#endif

constexpr int NWAVES = 8, NTHR = 512;
constexpr int DM = 2048, NB = 4, SEQ = 4096, CTXL = 256;
constexpr int ML = NB * SEQ, MC = NB * CTXL, MA = ML + MC;
constexpr int DFF = 5632, NUP = 2 * DFF, MODW = 9 * DM;
constexpr int NPROJ = 7168, KS_MOD = 16;
constexpr int NPHASE = 23;

constexpr size_t MiB = 1u << 20;
constexpr size_t WS_CTL = 0, CTL_ZERO_BYTES = 1 * MiB;
constexpr size_t WS_MODP = 1 * MiB;
constexpr size_t WS_MOD = 13 * MiB;
constexpr size_t WS_A3 = 14 * MiB;
constexpr size_t WS_ROTC = 15 * MiB, WS_ROTS = 16 * MiB;
constexpr size_t WS_WUP = 17 * MiB;
constexpr size_t WS_WDN = 193 * MiB;
constexpr size_t WS_WIN = 281 * MiB;
constexpr size_t WS_WOUT = 309 * MiB;
constexpr size_t WS_WPOOL = 317 * MiB;
constexpr size_t WS_X = 319 * MiB;
constexpr size_t WS_HN = 455 * MiB;
constexpr size_t WS_HID = 523 * MiB;
constexpr size_t WS_QKVG = 523 * MiB;
constexpr size_t WS_KVC = 651 * MiB;
constexpr size_t WS_YHT = 655 * MiB;
constexpr size_t WS_TC = 523 * MiB;
constexpr size_t WS_DD = 587 * MiB;
constexpr size_t WS_PHT = 710 * MiB;
constexpr size_t WS_SPREV = 806 * MiB;
constexpr size_t WS_KR = 870 * MiB;
constexpr size_t WS_END = 902 * MiB;
constexpr int CW_TMO = 0, CW_BAR = 4096;

namespace pg8 {
#define PG8_LAS __attribute__((address_space(3)))
typedef unsigned short bf16_t;
typedef short bf16x8 __attribute__((ext_vector_type(8)));
typedef float f32x4 __attribute__((ext_vector_type(4)));
typedef unsigned u32x4 __attribute__((ext_vector_type(4)));
constexpr int BM = 256, BK = 64, HALF = 128, HTB = HALF * BK * 2, STAGE_BYTES = 8 * HTB, NXCD = 8, WGM = 4;

__host__ __device__ __forceinline__ int lds_byte(int r, int c) { const int st = (r >> 4) * 2 + (c >> 5), rr = r & 15, cc = c & 31, ob = rr * 64 + cc * 2; return st * 1024 + (ob ^ (((ob >> 9) & 1) << 5)); }
__host__ __device__ __forceinline__ void stage_rc(int b, int& R, int& C) { const int st = b / 1024, sb = b % 1024, swz = sb ^ (((sb >> 9) & 1) << 5); R = (st >> 1) * 16 + swz / 64; C = (st & 1) * 32 + (swz % 64) / 2; }
__host__ __device__ __forceinline__ int perm32(int rho) { const int n = rho >> 4, i = rho & 15; return 8 * (i >> 2) + 4 * n + (i & 3); }

struct Unit { int pm, pn, ty; const char* A; const char* B; };
struct Gemm { int K, lda, ldb; };

__device__ __forceinline__ void tile_of(int L, int nM, int nN, int& pm, int& pn) {
    const int nwg = nM * nN; int wgid = L;
    { const int q = nwg / NXCD, r = nwg % NXCD, xcd = wgid % NXCD, off = wgid / NXCD; wgid = (xcd < r ? xcd * (q + 1) : r * (q + 1) + (xcd - r) * q) + off; }
    const int nig = WGM * nN, gid = wgid / nig, fm = gid * WGM, gsz = (nM - fm) < WGM ? (nM - fm) : WGM;
    pm = fm + ((wgid % nig) % gsz); pn = (wgid % nig) / gsz;
}
struct StaticOrder {
    int nM, nN, nwg, G, c; const char* A; const char* B; size_t astep, bstep;
    __device__ void init(const void* A_, const void* B_, int M, int N, int lda, int ldb, int G_, int c_) { nM = M / BM; nN = N / BM; nwg = nM * nN; G = G_; c = c_; A = (const char*)A_; B = (const char*)B_; astep = (size_t)BM * lda * 2; bstep = (size_t)BM * ldb * 2; }
    __device__ __forceinline__ bool next(int i, Unit& u) const {
        const long L = (long)i * G + c; if (L >= nwg) return false;
        tile_of((int)L, nM, nN, u.pm, u.pn); u.ty = 0; u.A = A + (size_t)u.pm * astep; u.B = B + (size_t)u.pn * bstep; return true;
    }
};

__device__ __forceinline__ unsigned cvt_pk_bf16(float lo, float hi) { unsigned r; asm volatile("v_cvt_pk_bf16_f32 %0, %1, %2" : "=v"(r) : "v"(lo), "v"(hi)); return r; }
__device__ __forceinline__ float silu_f(float a) { return a * __builtin_amdgcn_rcpf(1.0f + __builtin_amdgcn_exp2f(-1.44269504089f * a)); }


typedef int i32x8 __attribute__((ext_vector_type(8)));
typedef int i32x4 __attribute__((ext_vector_type(4)));
__device__ __forceinline__ float clamp_f8(float v) { return __builtin_fminf(__builtin_fmaxf(v, -448.0f), 448.0f); }
__device__ __forceinline__ unsigned pack4_fp8(float a, float b, float c, float d) {
    int w = __builtin_amdgcn_cvt_pk_fp8_f32(clamp_f8(a), clamp_f8(b), 0, false); w = __builtin_amdgcn_cvt_pk_fp8_f32(clamp_f8(c), clamp_f8(d), w, true); return (unsigned)w; }
constexpr float F8S_ACT = 16.0f, F8S_WUP = 256.0f, F8S_HID = 8.0f, F8S_WDN = 512.0f;

template <bool F8OUT> struct EpiSwiglu {
    static constexpr bool PERM = true;
    void* H; int ldh; float dsc;
    __device__ __forceinline__ void operator()(const f32x4 (&acc)[2][2][4][2], const Unit& u, int wr, int wc, int fr, int fq) const {
        const int row0 = u.pm * BM + wr * 64 + fr, col0 = u.pn * HALF + wc * 32 + 8 * fq;
#pragma unroll
        for (int ai = 0; ai < 2; ++ai)
#pragma unroll
            for (int m = 0; m < 4; ++m) {
                const f32x4 a0 = acc[ai][0][m][0] * dsc, a1 = acc[ai][0][m][1] * dsc, b0 = acc[ai][1][m][0] * dsc, b1 = acc[ai][1][m][1] * dsc;
                if constexpr (F8OUT) {
                    typedef unsigned u32x2_ __attribute__((ext_vector_type(2)));
                    u32x2_ w8;
                    w8.x = pack4_fp8(silu_f(a0[0]) * b0[0] * F8S_HID, silu_f(a0[1]) * b0[1] * F8S_HID, silu_f(a0[2]) * b0[2] * F8S_HID, silu_f(a0[3]) * b0[3] * F8S_HID);
                    w8.y = pack4_fp8(silu_f(a1[0]) * b1[0] * F8S_HID, silu_f(a1[1]) * b1[1] * F8S_HID, silu_f(a1[2]) * b1[2] * F8S_HID, silu_f(a1[3]) * b1[3] * F8S_HID);
                    *(u32x2_*)((unsigned char*)H + (size_t)(row0 + ai * HALF + m * 16) * ldh + col0) = w8;
                    continue;
                }
                u32x4 w;
                w.x = cvt_pk_bf16(silu_f(a0[0]) * b0[0], silu_f(a0[1]) * b0[1]); w.y = cvt_pk_bf16(silu_f(a0[2]) * b0[2], silu_f(a0[3]) * b0[3]);
                w.z = cvt_pk_bf16(silu_f(a1[0]) * b1[0], silu_f(a1[1]) * b1[1]); w.w = cvt_pk_bf16(silu_f(a1[2]) * b1[2], silu_f(a1[3]) * b1[3]);
                *(u32x4*)((bf16_t*)H + (size_t)(row0 + ai * HALF + m * 16) * ldh + col0) = w;
            }
    }
};
template <bool BF32> struct EpiResid {
    static constexpr bool PERM = true;
    const void* base_lat; const void* base_ctx; bf16_t* out; const float* gate; int gate_rstride; const float* gate2; float fac;
    __device__ __forceinline__ void operator()(const f32x4 (&acc)[2][2][4][2], const Unit& u, int wr, int wc, int fr, int fq) const {
        const int row0 = u.pm * BM + wr * 64 + fr, col0 = u.pn * BM + wc * 32 + 8 * fq;
        const int rb = u.pm < 64 ? (u.pm >> 4) : 4;
        const float* g = gate + (size_t)rb * gate_rstride;
        f32x4 gv[2][2];
#pragma unroll
        for (int bj = 0; bj < 2; ++bj)
#pragma unroll
            for (int n = 0; n < 2; ++n) { gv[bj][n] = *(const f32x4*)(g + col0 + bj * HALF + n * 4) * fac; if (gate2) gv[bj][n] = gv[bj][n] * *(const f32x4*)(gate2 + col0 + bj * HALF + n * 4); }
#define RES_OFF(R) ((size_t)(row0 + ((R) >> 2) * HALF + ((R) & 3) * 16) * 2048 + col0)
        if constexpr (BF32) {
            const float* base = u.pm < 64 ? (const float*)base_lat : ((const float*)base_ctx - (size_t)16384 * 2048);
            constexpr int AH = 3;
            f32x4 bs[8][2][2];
#define RES_LOAD(R) do { const size_t off_ = RES_OFF(R); _Pragma("unroll") for (int bj = 0; bj < 2; ++bj) _Pragma("unroll") for (int n = 0; n < 2; ++n) bs[R][bj][n] = *(const f32x4*)(base + off_ + bj * HALF + n * 4); } while (0)
#pragma unroll
            for (int R = 0; R < AH; ++R) RES_LOAD(R);
            __builtin_amdgcn_sched_barrier(0);
#pragma unroll
            for (int R = 0; R < 8; ++R) {
                if (R + AH < 8) RES_LOAD(R + AH);
                __builtin_amdgcn_sched_barrier(0);
                const size_t off = RES_OFF(R);
#pragma unroll
                for (int bj = 0; bj < 2; ++bj) { const f32x4 o0 = bs[R][bj][0] + gv[bj][0] * acc[R >> 2][bj][R & 3][0], o1 = bs[R][bj][1] + gv[bj][1] * acc[R >> 2][bj][R & 3][1];
                    u32x4 w; w.x = cvt_pk_bf16(o0[0], o0[1]); w.y = cvt_pk_bf16(o0[2], o0[3]); w.z = cvt_pk_bf16(o1[0], o1[1]); w.w = cvt_pk_bf16(o1[2], o1[3]);
                    *(u32x4*)(out + off + bj * HALF) = w; }
                __builtin_amdgcn_sched_barrier(0);
            }
#undef RES_LOAD
        } else {
            const bf16_t* base = (const bf16_t*)base_lat;
            constexpr int AHB = 3;
            u32x4 bs[8][2];
#define RES_LOADB(R) do { const size_t off_ = RES_OFF(R); _Pragma("unroll") for (int bj = 0; bj < 2; ++bj) bs[R][bj] = *(const u32x4*)(base + off_ + bj * HALF); } while (0)
#pragma unroll
            for (int R = 0; R < AHB; ++R) RES_LOADB(R);
            __builtin_amdgcn_sched_barrier(0);
#pragma unroll
            for (int R = 0; R < 8; ++R) { if (R + AHB < 8) RES_LOADB(R + AHB);
                __builtin_amdgcn_sched_barrier(0);
                const size_t off = RES_OFF(R);
#pragma unroll
                for (int bj = 0; bj < 2; ++bj) { const u32x4 r = bs[R][bj];
                    const f32x4 b0 = (f32x4){__builtin_bit_cast(float, r.x << 16), __builtin_bit_cast(float, r.x & 0xffff0000u), __builtin_bit_cast(float, r.y << 16), __builtin_bit_cast(float, r.y & 0xffff0000u)};
                    const f32x4 b1 = (f32x4){__builtin_bit_cast(float, r.z << 16), __builtin_bit_cast(float, r.z & 0xffff0000u), __builtin_bit_cast(float, r.w << 16), __builtin_bit_cast(float, r.w & 0xffff0000u)};
                    const f32x4 o0 = b0 + gv[bj][0] * acc[R >> 2][bj][R & 3][0], o1 = b1 + gv[bj][1] * acc[R >> 2][bj][R & 3][1];
                    u32x4 w; w.x = cvt_pk_bf16(o0[0], o0[1]); w.y = cvt_pk_bf16(o0[2], o0[3]); w.z = cvt_pk_bf16(o1[0], o1[1]); w.w = cvt_pk_bf16(o1[2], o1[3]);
                    *(u32x4*)(out + off + bj * HALF) = w; }
                __builtin_amdgcn_sched_barrier(0);
            }
        }
#undef RES_LOADB
#undef RES_OFF
    }
};
struct EpiWin {
    static constexpr bool PERM = true;
    unsigned char* wsb; const float* rc; const float* rs;
    __device__ __forceinline__ void operator()(const f32x4 (&acc)[2][2][4][2], const Unit& u, int wr, int wc, int fr, int fq) const {
        const int row0 = u.pm * BM + wr * 64 + fr;
        const int ty = u.ty;
        if (ty == 0 || ty == 1 || (ty == 5 && u.pn < 4)) {
            const int hsel = wc >> 1, j0 = 32 * (wc & 1) + 8 * fq;
            const float sc = (ty == 0) ? 1.0f : 0.08838834764831845f;
            bf16_t* dst = (bf16_t*)(wsb + ((ty == 5) ? WS_KVC : WS_QKVG)); const int ld = (ty == 5) ? 2048 : 4096;
            const int cbase = u.pn * BM + hsel * 128 + j0;
#pragma unroll
            for (int ai = 0; ai < 2; ++ai)
#pragma unroll
                for (int m = 0; m < 4; ++m) {
                    const int r = row0 + ai * HALF + m * 16;
                    f32x4 c0 = (f32x4){1.f, 1.f, 1.f, 1.f}, c1 = c0, s0 = (f32x4){0.f, 0.f, 0.f, 0.f}, s1 = s0;
                    if (ty != 5) { const size_t ti = (size_t)(r & 4095) * 64 + j0; c0 = *(const f32x4*)(rc + ti); c1 = *(const f32x4*)(rc + ti + 4); s0 = *(const f32x4*)(rs + ti); s1 = *(const f32x4*)(rs + ti + 4); }
                    const f32x4 x10 = acc[ai][0][m][0] * sc, x11 = acc[ai][0][m][1] * sc, x20 = acc[ai][1][m][0] * sc, x21 = acc[ai][1][m][1] * sc;
                    const f32x4 o10 = x10 * c0 - x20 * s0, o11 = x11 * c1 - x21 * s1, o20 = x20 * c0 + x10 * s0, o21 = x21 * c1 + x11 * s1;
                    u32x4 w1, w2;
                    w1.x = cvt_pk_bf16(o10[0], o10[1]); w1.y = cvt_pk_bf16(o10[2], o10[3]); w1.z = cvt_pk_bf16(o11[0], o11[1]); w1.w = cvt_pk_bf16(o11[2], o11[3]);
                    w2.x = cvt_pk_bf16(o20[0], o20[1]); w2.y = cvt_pk_bf16(o20[2], o20[3]); w2.z = cvt_pk_bf16(o21[0], o21[1]); w2.w = cvt_pk_bf16(o21[2], o21[3]);
                    bf16_t* p = dst + (size_t)r * ld + cbase;
                    *(u32x4*)p = w1; *(u32x4*)(p + 64) = w2;
                }
        } else {
            bf16_t* dst = (bf16_t*)(wsb + ((ty == 4) ? WS_PHT : (ty == 5 ? WS_KVC : WS_QKVG))); const int ld = (ty == 4) ? 16384 : (ty == 5 ? 2048 : 4096);
            const int col0 = u.pn * BM + wc * 32 + 8 * fq;
#pragma unroll
            for (int ai = 0; ai < 2; ++ai)
#pragma unroll
                for (int m = 0; m < 4; ++m) { bf16_t* rowp = dst + (size_t)(row0 + ai * HALF + m * 16) * ld + col0;
#pragma unroll
                    for (int bj = 0; bj < 2; ++bj) { f32x4 v0 = acc[ai][bj][m][0], v1 = acc[ai][bj][m][1];
                        if (ty == 3) { v0 = (f32x4){silu_f(v0[0]), silu_f(v0[1]), silu_f(v0[2]), silu_f(v0[3])}; v1 = (f32x4){silu_f(v1[0]), silu_f(v1[1]), silu_f(v1[2]), silu_f(v1[3])}; }
                        u32x4 w; w.x = cvt_pk_bf16(v0[0], v0[1]); w.y = cvt_pk_bf16(v0[2], v0[3]); w.z = cvt_pk_bf16(v1[0], v1[1]); w.w = cvt_pk_bf16(v1[2], v1[3]);
                        *(u32x4*)(rowp + bj * HALF) = w; } }
        }
    }
};

template <class Epi, class Sched, bool ALIGN_EPI = false, bool SP2 = false, bool F8 = false>
__device__ __forceinline__ void gemm_phase(PG8_LAS unsigned char* lds, const Gemm g, const Sched& S, const Epi& E) {
    const int tid = threadIdx.x, wid = __builtin_amdgcn_readfirstlane(tid >> 6), lane = tid & 63, wr = wid >> 2, wc = wid & 3, fr = lane & 15, fq = lane >> 4;
    const int K = g.K, nt = K / BK;
    unsigned voffA[2], voffB[2];
#pragma unroll
    for (int i = 0; i < 2; ++i) { int R, C; stage_rc(tid * 16 + i * 8192, R, C); const int Rb = Epi::PERM ? ((R & ~31) + perm32(R & 31)) : R;
        voffA[i] = (unsigned)(R * g.lda + C) * 2u; voffB[i] = (unsigned)(Rb * g.ldb + C) * 2u; }
    const size_t kstep = (size_t)(BK * 2);
    const size_t hsA = (size_t)HALF * g.lda * 2, hsB = (size_t)HALF * g.ldb * 2;
    const unsigned ldsw = (unsigned)wid * 1024u;
    const int aoff = lds_byte(wr * 64 + fr, fq * 8), boff = lds_byte(wc * 32 + fr, fq * 8);
    const int a8o0 = lds_byte(wr * 64 + fr, 16 * fq + 8 * (fq & 1)), a8o1 = lds_byte(wr * 64 + fr, 16 * fq + 8 * (1 - (fq & 1)));
    const int b8o0 = lds_byte(wc * 32 + fr, 16 * fq + 8 * (fq & 1)), b8o1 = lds_byte(wc * 32 + fr, 16 * fq + 8 * (1 - (fq & 1)));
#define PG8_LDA8(dst, b, h) do { _Pragma("unroll") for (int m = 0; m < 4; ++m) { const i32x4 lo_ = *(const PG8_LAS i32x4*)(lds + PG8_SA(b, h) + a8o0 + m * 2048), hi_ = *(const PG8_LAS i32x4*)(lds + PG8_SA(b, h) + a8o1 + m * 2048); \
        dst[m] = __builtin_shufflevector(lo_, hi_, 0, 1, 2, 3, 4, 5, 6, 7); } } while (0)
#define PG8_LDB8(dst, b, h) do { _Pragma("unroll") for (int n = 0; n < 2; ++n) { const i32x4 lo_ = *(const PG8_LAS i32x4*)(lds + PG8_SB(b, h) + b8o0 + n * 2048), hi_ = *(const PG8_LAS i32x4*)(lds + PG8_SB(b, h) + b8o1 + n * 2048); \
        dst[n] = __builtin_shufflevector(lo_, hi_, 0, 1, 2, 3, 4, 5, 6, 7); } } while (0)
#define PG8_MMA8(ai, bj, At, Bt) do { __builtin_amdgcn_s_setprio(1); _Pragma("unroll") for (int m = 0; m < 4; ++m) _Pragma("unroll") for (int n = 0; n < 2; ++n) \
        asm volatile("v_mfma_scale_f32_16x16x128_f8f6f4 %0, %1, %2, %0, %3, %3 op_sel_hi:[0,0,0]" : "+v"(acc[ai][bj][m][n]) : "v"(Bt[n]), "v"(At[m]), "v"(f8scale)); __builtin_amdgcn_s_setprio(0); } while (0)
#define PG8_SA(b, h) (((b) * 2 + (h)) * HTB)
#define PG8_SB(b, h) ((4 + (b) * 2 + (h)) * HTB)
#define PG8_STAGE(bufoff, gbase, voff) do { _Pragma("unroll") for (int _i = 0; _i < 2; ++_i) \
        __builtin_amdgcn_global_load_lds((const unsigned*)((const char*)(gbase) + (voff)[_i]), (PG8_LAS unsigned*)(lds + (bufoff) + ldsw + _i * 8192), 16, 0, 0); } while (0)
#define PG8_LDA(dst, b, h) do { _Pragma("unroll") for (int m = 0; m < 4; ++m) _Pragma("unroll") for (int k = 0; k < 2; ++k) dst[m][k] = *(const PG8_LAS bf16x8*)(lds + PG8_SA(b, h) + aoff + m * 2048 + k * 1024); } while (0)
#define PG8_LDB(dst, b, h) do { _Pragma("unroll") for (int n = 0; n < 2; ++n) _Pragma("unroll") for (int k = 0; k < 2; ++k) dst[n][k] = *(const PG8_LAS bf16x8*)(lds + PG8_SB(b, h) + boff + n * 2048 + k * 1024); } while (0)
#define PG8_MMA(ai, bj, At, Bt) do { __builtin_amdgcn_s_setprio(1); _Pragma("unroll") for (int m = 0; m < 4; ++m) _Pragma("unroll") for (int n = 0; n < 2; ++n) _Pragma("unroll") for (int k = 0; k < 2; ++k) \
        acc[ai][bj][m][n] = __builtin_amdgcn_mfma_f32_16x16x32_bf16(Bt[n][k], At[m][k], acc[ai][bj][m][n], 0, 0, 0); __builtin_amdgcn_s_setprio(0); } while (0)
#define PG8_WAIT_V(n) asm volatile("s_waitcnt vmcnt(" #n ")" ::: "memory")
#define PG8_WAIT_L(n) asm volatile("s_waitcnt lgkmcnt(" #n ")" ::: "memory")
#define PG8_BAR __builtin_amdgcn_s_barrier()
#define PG8_SCHED __builtin_amdgcn_sched_barrier(0)
    Unit cur, nxt; int ui = 0;
    if (!S.next(0, cur)) return;
    f32x4 acc[2][2][4][2];
#pragma unroll
    for (int a = 0; a < 2; ++a)
#pragma unroll
        for (int b = 0; b < 2; ++b)
#pragma unroll
            for (int m = 0; m < 4; ++m)
#pragma unroll
                for (int n = 0; n < 2; ++n) acc[a][b][m][n] = (f32x4){0.f, 0.f, 0.f, 0.f};
    bf16x8 At[4][2], B0[2][2], B1[2][2];
    i32x8 At8[4], B08[2], B18[2];
    int f8scale = 0x7f7f7f7f; asm volatile("" : "+v"(f8scale));
    const char* cA = cur.A; const char* cB = cur.B;
    if constexpr (SP2) {
        PG8_STAGE(PG8_SB(0, 0), cB, voffB); PG8_STAGE(PG8_SB(0, 1), cB + hsB, voffB); PG8_STAGE(PG8_SA(0, 0), cA, voffA); PG8_STAGE(PG8_SA(0, 1), cA + hsA, voffA);
        if (wr == 1) PG8_BAR;
        PG8_WAIT_V(2); PG8_BAR;
        PG8_STAGE(PG8_SB(1, 0), cB + kstep, voffB); PG8_STAGE(PG8_SA(1, 0), cA + kstep, voffA); PG8_STAGE(PG8_SB(1, 1), cB + hsB + kstep, voffB);
        PG8_WAIT_V(6); PG8_BAR;
    } else {
        PG8_STAGE(PG8_SB(0, 0), cB, voffB); PG8_STAGE(PG8_SA(0, 0), cA, voffA); PG8_STAGE(PG8_SB(0, 1), cB + hsB, voffB); PG8_STAGE(PG8_SA(0, 1), cA + hsA, voffA);
        if (wr == 1) PG8_BAR;
        PG8_WAIT_V(4); PG8_BAR;
        PG8_STAGE(PG8_SB(1, 0), cB + kstep, voffB); PG8_STAGE(PG8_SA(1, 0), cA + kstep, voffA); PG8_STAGE(PG8_SB(1, 1), cB + hsB + kstep, voffB);
        PG8_WAIT_V(6); PG8_BAR;
    }
    for (;;) {
        const bool has_next = S.next(ui + 1, nxt);
        const char* nA = has_next ? nxt.A : cA; const char* nB = has_next ? nxt.B : cB;
        for (int t = 0; t < nt; t += 2) {
            const bool last = (t == nt - 2);
            const char* a1 = cA + (size_t)(t + 1) * kstep;
            const char* a2 = last ? nA : cA + (size_t)(t + 2) * kstep; const char* b2 = last ? nB : cB + (size_t)(t + 2) * kstep;
            const char* a3 = a2 + kstep; const char* b3 = b2 + kstep;
            if constexpr (SP2 && F8) {
            PG8_LDB8(B08, 0, 0); PG8_LDB8(B18, 0, 1); PG8_SCHED; PG8_LDA8(At8, 0, 0); PG8_STAGE(PG8_SA(1, 1), a1 + hsA, voffA);
            PG8_WAIT_V(8); PG8_WAIT_L(0); PG8_BAR; PG8_MMA8(0, 0, At8, B08); PG8_MMA8(0, 1, At8, B18); PG8_BAR; PG8_SCHED;
            PG8_LDA8(At8, 0, 1); PG8_STAGE(PG8_SB(0, 0), b2, voffB); PG8_STAGE(PG8_SB(0, 1), b2 + hsB, voffB); PG8_STAGE(PG8_SA(0, 0), a2, voffA);
            PG8_WAIT_V(8); PG8_WAIT_L(0); PG8_BAR; PG8_MMA8(1, 0, At8, B08); PG8_MMA8(1, 1, At8, B18); PG8_BAR; PG8_SCHED;
            PG8_LDB8(B08, 1, 0); PG8_LDB8(B18, 1, 1); PG8_SCHED; PG8_LDA8(At8, 1, 0); PG8_STAGE(PG8_SA(0, 1), a2 + hsA, voffA);
            PG8_WAIT_V(8); PG8_WAIT_L(0); PG8_BAR; PG8_MMA8(0, 0, At8, B08); PG8_MMA8(0, 1, At8, B18); PG8_BAR; PG8_SCHED;
            PG8_LDA8(At8, 1, 1); PG8_STAGE(PG8_SB(1, 0), b3, voffB); PG8_STAGE(PG8_SB(1, 1), b3 + hsB, voffB); PG8_STAGE(PG8_SA(1, 0), a3, voffA);
            PG8_WAIT_V(8); PG8_WAIT_L(0); PG8_BAR; PG8_MMA8(1, 0, At8, B08); PG8_MMA8(1, 1, At8, B18); PG8_BAR; PG8_SCHED;
            } else if constexpr (SP2) {
            PG8_LDB(B0, 0, 0); PG8_LDB(B1, 0, 1); PG8_SCHED; PG8_LDA(At, 0, 0); PG8_STAGE(PG8_SA(1, 1), a1 + hsA, voffA);
            PG8_WAIT_V(8); PG8_WAIT_L(0); PG8_BAR; PG8_MMA(0, 0, At, B0); PG8_MMA(0, 1, At, B1); PG8_BAR; PG8_SCHED;
            PG8_LDA(At, 0, 1); PG8_STAGE(PG8_SB(0, 0), b2, voffB); PG8_STAGE(PG8_SB(0, 1), b2 + hsB, voffB); PG8_STAGE(PG8_SA(0, 0), a2, voffA);
            PG8_WAIT_V(8); PG8_WAIT_L(0); PG8_BAR; PG8_MMA(1, 0, At, B0); PG8_MMA(1, 1, At, B1); PG8_BAR; PG8_SCHED;
            PG8_LDB(B0, 1, 0); PG8_LDB(B1, 1, 1); PG8_SCHED; PG8_LDA(At, 1, 0); PG8_STAGE(PG8_SA(0, 1), a2 + hsA, voffA);
            PG8_WAIT_V(8); PG8_WAIT_L(0); PG8_BAR; PG8_MMA(0, 0, At, B0); PG8_MMA(0, 1, At, B1); PG8_BAR; PG8_SCHED;
            PG8_LDA(At, 1, 1); PG8_STAGE(PG8_SB(1, 0), b3, voffB); PG8_STAGE(PG8_SB(1, 1), b3 + hsB, voffB); PG8_STAGE(PG8_SA(1, 0), a3, voffA);
            PG8_WAIT_V(8); PG8_WAIT_L(0); PG8_BAR; PG8_MMA(1, 0, At, B0); PG8_MMA(1, 1, At, B1); PG8_BAR; PG8_SCHED;
            } else {
            PG8_LDB(B0, 0, 0); PG8_SCHED; PG8_LDA(At, 0, 0); PG8_STAGE(PG8_SA(1, 1), a1 + hsA, voffA);
            PG8_WAIT_L(8); PG8_BAR; PG8_WAIT_L(0); PG8_MMA(0, 0, At, B0); PG8_BAR; PG8_SCHED;
            PG8_LDB(B1, 0, 1); PG8_STAGE(PG8_SB(0, 0), b2, voffB);
            PG8_BAR; PG8_WAIT_L(0); PG8_MMA(0, 1, At, B1); PG8_BAR;
            PG8_LDA(At, 0, 1); PG8_STAGE(PG8_SA(0, 0), a2, voffA);
            PG8_BAR; PG8_WAIT_L(0); PG8_MMA(1, 0, At, B0); PG8_BAR; PG8_SCHED;
            PG8_STAGE(PG8_SB(0, 1), b2 + hsB, voffB);
            PG8_WAIT_V(6); PG8_BAR; PG8_MMA(1, 1, At, B1); PG8_BAR;
            PG8_LDB(B0, 1, 0); PG8_SCHED; PG8_LDA(At, 1, 0); PG8_STAGE(PG8_SA(0, 1), a2 + hsA, voffA);
            PG8_WAIT_L(8); PG8_BAR; PG8_WAIT_L(0); PG8_MMA(0, 0, At, B0); PG8_BAR; PG8_SCHED;
            PG8_LDB(B1, 1, 1); PG8_STAGE(PG8_SB(1, 0), b3, voffB);
            PG8_BAR; PG8_WAIT_L(0); PG8_MMA(0, 1, At, B1); PG8_BAR;
            PG8_LDA(At, 1, 1); PG8_STAGE(PG8_SA(1, 0), a3, voffA);
            PG8_BAR; PG8_WAIT_L(0); PG8_MMA(1, 0, At, B0); PG8_BAR; PG8_SCHED;
            PG8_STAGE(PG8_SB(1, 1), b3 + hsB, voffB);
            PG8_WAIT_V(6); PG8_BAR; PG8_MMA(1, 1, At, B1); PG8_BAR;
            }
        }
        if constexpr (ALIGN_EPI) { if (wr == 0) PG8_BAR; }
        if constexpr (F8) asm volatile("s_nop 15\n\ts_nop 15" ::: "memory");
        E(acc, cur, wr, wc, fr, fq);
        if (!has_next) break;
#pragma unroll
        for (int a = 0; a < 2; ++a)
#pragma unroll
            for (int b = 0; b < 2; ++b)
#pragma unroll
                for (int m = 0; m < 4; ++m)
#pragma unroll
                    for (int n = 0; n < 2; ++n) acc[a][b][m][n] = (f32x4){0.f, 0.f, 0.f, 0.f};
        cur = nxt; cA = nA; cB = nB; ++ui;
        if constexpr (ALIGN_EPI) { if (wr == 1) PG8_BAR; }
    }
    PG8_WAIT_V(0);
    if constexpr (!ALIGN_EPI) { if (wr == 0) PG8_BAR; }
    PG8_BAR;
#undef PG8_LDA8
#undef PG8_LDB8
#undef PG8_MMA8
#undef PG8_SA
#undef PG8_SB
#undef PG8_STAGE
#undef PG8_LDA
#undef PG8_LDB
#undef PG8_MMA
#undef PG8_WAIT_V
#undef PG8_WAIT_L
#undef PG8_BAR
#undef PG8_SCHED
}
}

constexpr int LDS_BYTES = 147456;
constexpr int MISC_OFF = LDS_BYTES - 256;

#define GAS __attribute__((address_space(1)))
#define LAS __attribute__((address_space(3)))
typedef unsigned short bf16;
typedef unsigned v4u __attribute__((ext_vector_type(4)));
typedef unsigned v2u __attribute__((ext_vector_type(2)));
typedef float f32x4 __attribute__((ext_vector_type(4)));
typedef short bf16x8 __attribute__((ext_vector_type(8)));
typedef short s16x4 __attribute__((ext_vector_type(4)));
typedef GAS unsigned gu32;
#define RLX_AGENT __ATOMIC_RELAXED, __HIP_MEMORY_SCOPE_AGENT
#define LDS_WAIT() asm volatile("s_waitcnt lgkmcnt(0)" ::: "memory")
#define LDS_BARRIER() asm volatile("s_waitcnt lgkmcnt(0)\n\ts_barrier" ::: "memory")
#define VM_WAIT() asm volatile("s_waitcnt vmcnt(0)" ::: "memory")
__device__ __forceinline__ unsigned pk2(float lo, float hi) { unsigned r; asm("v_cvt_pk_bf16_f32 %0, %1, %2" : "=v"(r) : "v"(lo), "v"(hi)); return r; }
__device__ __forceinline__ unsigned f2bf(float f) { return pk2(f, 0.0f) & 0xffffu; }
__device__ __forceinline__ float bf2f(unsigned short b) { return __builtin_bit_cast(float, (unsigned)b << 16); }
__device__ __forceinline__ float bflo(unsigned w) { return __builtin_bit_cast(float, w << 16); }
__device__ __forceinline__ float bfhi(unsigned w) { return __builtin_bit_cast(float, w & 0xffff0000u); }
__device__ __forceinline__ float fexp(float x) { return __builtin_amdgcn_exp2f(x * 1.44269504089f); }
__device__ __forceinline__ float wave_sum(float v) {
#pragma unroll
    for (int o = 1; o < 64; o <<= 1) v += __shfl_xor(v, o);
    return v;
}

#define XB_TMO      128
#define XB_XCNT(j)  (256  + 64 * (j))
#define XB_XSUB(j)  (1280 + 64 * (j))
#define XB_XGEN(j)  (2304 + 64 * (j))
#define XB_TOP      3328
#define XB_TOPGEN   3392
#define XCD_BAR_WORDS 3456
#define XB_SPIN_CAP (1u << 21)
__device__ __forceinline__ unsigned xb_ld(unsigned* p)              { return __hip_atomic_load(p, __ATOMIC_RELAXED, __HIP_MEMORY_SCOPE_AGENT); }
__device__ __forceinline__ unsigned xb_add(unsigned* p, unsigned v) { return __hip_atomic_fetch_add(p, v, __ATOMIC_RELAXED, __HIP_MEMORY_SCOPE_AGENT); }
__device__ __forceinline__ unsigned xb_xcc_id() { return (unsigned)__builtin_amdgcn_s_getreg((3 << 11) | 20) & 0xFu; }
#define XB_SPIN(cond, bar) do { unsigned _sp = 0; while (cond) { __builtin_amdgcn_s_sleep(1); \
    if ((++_sp & 255u) == 0u) { if (xb_ld(&(bar)[XB_TMO])) break; if (_sp > XB_SPIN_CAP) { atomicAdd(&(bar)[XB_TMO], 1u); break; } } } } while (0)
struct XcdBarrier { unsigned* bar; unsigned x; volatile LAS unsigned* st; };
__device__ __forceinline__ XcdBarrier xcd_barrier_post(unsigned* bar, volatile LAS unsigned* st) {
    XcdBarrier b; b.bar = bar; b.x = xb_xcc_id(); b.st = st;
    if (threadIdx.x == 0) (void)xb_add(&bar[XB_XCNT(b.x)], 1u);
    return b;
}
__device__ __forceinline__ void xcd_barrier_complete(unsigned* bar, unsigned x, unsigned& nloc, unsigned& nx) {
    const unsigned G = gridDim.x * gridDim.y * gridDim.z;
    unsigned sum, cnt, mine, sp = 0u;
    for (;;) {
        sum = 0u; cnt = 0u; mine = 0u;
#pragma unroll
        for (unsigned j = 0; j < 16; ++j) { const unsigned c = xb_ld(&bar[XB_XCNT(j)]); sum += c; cnt += (c > 0u) ? 1u : 0u; mine = (j == x) ? c : mine; }
        if (sum == G) break;
        __builtin_amdgcn_s_sleep(1);
        if ((++sp & 255u) == 0u) { if (xb_ld(&bar[XB_TMO])) break; if (sp > XB_SPIN_CAP) { atomicAdd(&bar[XB_TMO], 1u); break; } }
    }
    nloc = mine > 0u ? mine : 1u; nx = cnt > 0u ? cnt : 1u;
}
__device__ __forceinline__ void xcd_barrier(const XcdBarrier& b) {
    asm volatile("s_waitcnt vmcnt(0)" ::: "memory");
    __syncthreads();
    if (threadIdx.x == 0) {
        unsigned* bar = b.bar;
        __builtin_amdgcn_s_waitcnt(0);
        unsigned nloc = b.st[0], nx = b.st[1];
        if (nloc == 0u) { xcd_barrier_complete(bar, b.x, nloc, nx); b.st[0] = nloc; b.st[1] = nx; }
        const unsigned old = xb_add(&bar[XB_XSUB(b.x)], 1u);
        const unsigned gen = old / nloc;
        if (old + 1u == (gen + 1u) * nloc) {
            __builtin_amdgcn_fence(__ATOMIC_RELEASE, "agent");
            asm volatile("s_waitcnt vmcnt(0)" ::: "memory");
            const unsigned og = xb_add(&bar[XB_TOP], 1u);
            const unsigned tg = og / nx;
            if (og + 1u == (tg + 1u) * nx) xb_add(&bar[XB_TOPGEN], 1u);
            else XB_SPIN(xb_ld(&bar[XB_TOPGEN]) == tg, bar);
            __builtin_amdgcn_fence(__ATOMIC_ACQUIRE, "agent");
            xb_add(&bar[XB_XGEN(b.x)], 1u);
            asm volatile("s_waitcnt vmcnt(0)" ::: "memory");
        } else {
            XB_SPIN(xb_ld(&bar[XB_XGEN(b.x)]) == gen, bar);
            __builtin_amdgcn_fence(__ATOMIC_ACQUIRE, "agent");
            asm volatile("s_waitcnt vmcnt(0)" ::: "memory");
        }
    }
    __syncthreads();
}

struct Args { const float* in[29]; float* out; unsigned char* ws; int ph_lo, ph_hi; };
enum { I_X = 0, I_C, I_CTX, I_CCTX, I_WMOD, I_BMOD, I_F1W1, I_F1W3, I_F1W2, I_F2W1, I_F2W3, I_F2W2, I_WIN, I_WOUT, I_LOGD, I_CONVW, I_CONVB,
       I_FW1, I_FB1, I_FW2, I_FB2, I_FW3, I_FB3, I_FREQ, I_FW4, I_HYB, I_POOLW, I_POOLS, I_FGAIN };

struct Frame {
    LAS unsigned char* lds;
    int tid, lane, wave, G, gw, NGW;
};

__device__ __forceinline__ void conv_item(const float* W, int N, bf16* WT, int K, int k0, int n0, int drow, int lane) {
    const float* p = W + (size_t)k0 * N + n0 + lane;
    float v[64];
#pragma unroll
    for (int i = 0; i < 64; ++i) v[i] = __builtin_nontemporal_load((const GAS float*)(p + (size_t)i * N));
    bf16* o = WT + (size_t)drow * K + k0;
#pragma unroll
    for (int q = 0; q < 8; ++q) { v4u w; w.x = pk2(v[8 * q], v[8 * q + 1]); w.y = pk2(v[8 * q + 2], v[8 * q + 3]); w.z = pk2(v[8 * q + 4], v[8 * q + 5]); w.w = pk2(v[8 * q + 6], v[8 * q + 7]);
        *(GAS v4u*)(o + 8 * q) = w; }
}
__device__ __forceinline__ void conv_item8(const float* W, int N, unsigned char* WT, int Kb, int k0, int n0, int drow, float scale, int lane) {
    const float* p = W + (size_t)k0 * N + n0 + lane;
    float v[64];
#pragma unroll
    for (int i = 0; i < 64; ++i) v[i] = __builtin_nontemporal_load((const GAS float*)(p + (size_t)i * N));
    unsigned char* o = WT + (size_t)drow * Kb + k0;
#pragma unroll
    for (int q = 0; q < 4; ++q) { v4u w;
        w.x = pg8::pack4_fp8(v[16 * q] * scale, v[16 * q + 1] * scale, v[16 * q + 2] * scale, v[16 * q + 3] * scale); w.y = pg8::pack4_fp8(v[16 * q + 4] * scale, v[16 * q + 5] * scale, v[16 * q + 6] * scale, v[16 * q + 7] * scale);
        w.z = pg8::pack4_fp8(v[16 * q + 8] * scale, v[16 * q + 9] * scale, v[16 * q + 10] * scale, v[16 * q + 11] * scale); w.w = pg8::pack4_fp8(v[16 * q + 12] * scale, v[16 * q + 13] * scale, v[16 * q + 14] * scale, v[16 * q + 15] * scale);
        *(GAS v4u*)(o + 16 * q) = w; }
}

__device__ __forceinline__ f32x4 mod_from_partials(const float* modp, const float* bmod, int layer, int r, int col) {
    f32x4 s = *(const f32x4*)(bmod + (size_t)layer * MODW + col);
#pragma unroll 4
    for (int ks = 0; ks < KS_MOD; ++ks) s += *(const f32x4*)(modp + ((size_t)((ks * 2 + layer) * 5 + r)) * MODW + col);
    return s;
}

__device__ __forceinline__ void norm_pass(Frame& F, const float* src_lat, const float* src_ctx, int nrows, const float* mod, const float* modp, const float* bmod, int layer, int j, bf16* HNo, bool f8out) {
    LAS float* SS = (LAS float*)F.lds;
    const int per = nrows / F.G, rbeg = blockIdx.x * per, rend = rbeg + per;
    int sbeg = rbeg;
    while (sbeg < rend) {
        const int rb = sbeg < ML ? sbeg / SEQ : 4;
        int send = sbeg < ML ? (rb + 1) * SEQ : rend; if (send > rend) send = rend;
        __syncthreads();
        for (int c4 = F.tid; c4 < 2 * DM / 4; c4 += NTHR) { const int which = c4 / (DM / 4), col = (c4 % (DM / 4)) * 4;
            f32x4 v = modp ? mod_from_partials(modp, bmod, layer, rb, (j + which) * DM + col) : *(const f32x4*)(mod + ((size_t)(layer * 5 + rb) * 9 + j + which) * DM + col);
            *(LAS f32x4*)(SS + which * DM + col) = v; }
        __syncthreads();
        int row = sbeg + F.wave;
        f32x4 vn[8];
        if (row < send) { const float* xr = row < ML ? src_lat + (size_t)row * DM : src_ctx + (size_t)(row - ML) * DM;
#pragma unroll
            for (int q = 0; q < 8; ++q) vn[q] = *(const GAS f32x4*)(xr + 4 * F.lane + 256 * q); }
        while (row < send) {
            f32x4 v[8]; float s2 = 0.f;
#pragma unroll
            for (int q = 0; q < 8; ++q) v[q] = vn[q];
            const int rn = row + NWAVES;
            if (rn < send) { const float* xr = rn < ML ? src_lat + (size_t)rn * DM : src_ctx + (size_t)(rn - ML) * DM;
#pragma unroll
                for (int q = 0; q < 8; ++q) vn[q] = *(const GAS f32x4*)(xr + 4 * F.lane + 256 * q); }
#pragma unroll
            for (int q = 0; q < 8; ++q) s2 += (v[q].x * v[q].x + v[q].y * v[q].y) + (v[q].z * v[q].z + v[q].w * v[q].w);
            const float rstd = 1.0f / sqrtf(wave_sum(s2) * (1.0f / DM) + 1e-6f);
            bf16* orow = HNo + (size_t)row * DM;
#pragma unroll
            for (int q = 0; q < 8; ++q) { const int col = 4 * F.lane + 256 * q; const f32x4 sh = *(const LAS f32x4*)(SS + col), sc = *(const LAS f32x4*)(SS + DM + col);
                const f32x4 o = v[q] * rstd * (sc + 1.0f) + sh;
                if (f8out) { *(GAS unsigned*)((unsigned char*)HNo + (size_t)row * DM + col) = pg8::pack4_fp8(o.x * pg8::F8S_ACT, o.y * pg8::F8S_ACT, o.z * pg8::F8S_ACT, o.w * pg8::F8S_ACT); }
                else { v2u w; w.x = pk2(o.x, o.y); w.y = pk2(o.z, o.w); *(GAS v2u*)(orow + col) = w; } }
            row = rn;
        }
        sbeg = send;
    }
    __syncthreads();
}

__device__ __forceinline__ void norm_pass_h(Frame& F, const bf16* XHs, int nrows, const float* mod, int layer, int j, bf16* HNo, bool f8out, const float* modp = nullptr, const float* bmod = nullptr) {
    LAS float* SS = (LAS float*)F.lds;
    const int per = nrows / F.G, rbeg = blockIdx.x * per, rend = rbeg + per;
    int sbeg = rbeg;
    while (sbeg < rend) {
        const int rb = sbeg < ML ? sbeg / SEQ : 4;
        int send = sbeg < ML ? (rb + 1) * SEQ : rend; if (send > rend) send = rend;
        __syncthreads();
        for (int c4 = F.tid; c4 < 2 * DM / 4; c4 += NTHR) { const int which = c4 / (DM / 4), col = (c4 % (DM / 4)) * 4;
            *(LAS f32x4*)(SS + which * DM + col) = modp ? mod_from_partials(modp, bmod, layer, rb, (j + which) * DM + col) : *(const f32x4*)(mod + ((size_t)(layer * 5 + rb) * 9 + j + which) * DM + col); }
        __syncthreads();
        int row = sbeg + F.wave;
        v4u vn[4];
        if (row < send) {
#pragma unroll
            for (int q = 0; q < 4; ++q) vn[q] = *(const GAS v4u*)(XHs + (size_t)row * DM + 8 * F.lane + 512 * q); }
        while (row < send) {
            v4u v[4]; float s2 = 0.f;
#pragma unroll
            for (int q = 0; q < 4; ++q) v[q] = vn[q];
            const int rn = row + NWAVES;
            if (rn < send) {
#pragma unroll
                for (int q = 0; q < 4; ++q) vn[q] = *(const GAS v4u*)(XHs + (size_t)rn * DM + 8 * F.lane + 512 * q); }
            f32x4 x0[4], x1[4];
#pragma unroll
            for (int q = 0; q < 4; ++q) { x0[q] = (f32x4){bflo(v[q].x), bfhi(v[q].x), bflo(v[q].y), bfhi(v[q].y)}; x1[q] = (f32x4){bflo(v[q].z), bfhi(v[q].z), bflo(v[q].w), bfhi(v[q].w)};
                s2 += ((x0[q].x * x0[q].x + x0[q].y * x0[q].y) + (x0[q].z * x0[q].z + x0[q].w * x0[q].w)) + ((x1[q].x * x1[q].x + x1[q].y * x1[q].y) + (x1[q].z * x1[q].z + x1[q].w * x1[q].w)); }
            const float rstd = 1.0f / sqrtf(wave_sum(s2) * (1.0f / DM) + 1e-6f);
#pragma unroll
            for (int q = 0; q < 4; ++q) { const int col = 8 * F.lane + 512 * q;
                const f32x4 o0 = x0[q] * rstd * (*(const LAS f32x4*)(SS + DM + col) + 1.0f) + *(const LAS f32x4*)(SS + col);
                const f32x4 o1 = x1[q] * rstd * (*(const LAS f32x4*)(SS + DM + col + 4) + 1.0f) + *(const LAS f32x4*)(SS + col + 4);
                if (f8out) { v2u w; w.x = pg8::pack4_fp8(o0.x * pg8::F8S_ACT, o0.y * pg8::F8S_ACT, o0.z * pg8::F8S_ACT, o0.w * pg8::F8S_ACT); w.y = pg8::pack4_fp8(o1.x * pg8::F8S_ACT, o1.y * pg8::F8S_ACT, o1.z * pg8::F8S_ACT, o1.w * pg8::F8S_ACT);
                    *(GAS v2u*)((unsigned char*)HNo + (size_t)row * DM + col) = w; }
                else { v4u w; w.x = pk2(o0.x, o0.y); w.y = pk2(o0.z, o0.w); w.z = pk2(o1.x, o1.y); w.w = pk2(o1.z, o1.w); *(GAS v4u*)(HNo + (size_t)row * DM + col) = w; } }
            row = rn;
        }
        sbeg = send;
    }
    __syncthreads();
}

__global__ void __launch_bounds__(NTHR, 2) mk_fwd(Args args) {
    extern __shared__ __attribute__((aligned(16))) unsigned char lds_raw[];
    Frame F;
    F.lds = (LAS unsigned char*)lds_raw;
    volatile LAS unsigned* MISC = (volatile LAS unsigned*)(F.lds + MISC_OFF);
    F.tid = threadIdx.x; F.lane = F.tid & 63; F.wave = __builtin_amdgcn_readfirstlane(F.tid >> 6);
    F.G = gridDim.x; F.gw = blockIdx.x * NWAVES + F.wave; F.NGW = F.G * NWAVES;
    unsigned char* ws = args.ws;
    gu32* ctl = (gu32*)(ws + WS_CTL);
    if (F.tid < 64) MISC[F.tid] = 0u;
    __syncthreads();
    XcdBarrier bar; bar.bar = (unsigned*)(ctl + CW_BAR); bar.x = 0; bar.st = nullptr;
    const int lo = args.ph_lo, hi = args.ph_hi;
    if (hi - lo > 1) bar = xcd_barrier_post((unsigned*)(ctl + CW_BAR), MISC + 8);
#define IN(k) (lo <= (k) && (k) < hi)
#define REP(k) for (int rep_ = 0; rep_ < ((DUP_PHASE) == (k) ? 2 : 1); ++rep_)
#define SEAM(k) do { if (IN(k) && IN((k) + 1)) xcd_barrier(bar); } while (0)

    float* modp = (float*)(ws + WS_MODP); float* mod = (float*)(ws + WS_MOD);
    float* A3 = (float*)(ws + WS_A3); float* rotc = (float*)(ws + WS_ROTC); float* rots = (float*)(ws + WS_ROTS);
    bf16* Wup = (bf16*)(ws + WS_WUP); bf16* Wdn = (bf16*)(ws + WS_WDN); bf16* Win = (bf16*)(ws + WS_WIN); bf16* Wout = (bf16*)(ws + WS_WOUT); bf16* Wpool = (bf16*)(ws + WS_WPOOL);
    bf16* XB = (bf16*)(ws + WS_X);
    bf16* HN = (bf16*)(ws + WS_HN); bf16* HID = (bf16*)(ws + WS_HID);
    bf16* QKVG = (bf16*)(ws + WS_QKVG); bf16* KVC = (bf16*)(ws + WS_KVC); bf16* YHT = (bf16*)(ws + WS_YHT); bf16* PHT = (bf16*)(ws + WS_PHT);
    bf16* SPREV = (bf16*)(ws + WS_SPREV); bf16* KR = (bf16*)(ws + WS_KR); bf16* TC = (bf16*)(ws + WS_TC); bf16* DD = (bf16*)(ws + WS_DD);
    bf16* A2 = HN;
    const size_t UPSZ = (size_t)NUP * DM, DNSZ = (size_t)DM * DFF;

    constexpr int NI_UP = 32 * 88, NI_DN = 88 * 32, NI_WIN = 32 * 112, NI_WOUT = 32 * 32, NI_POOL = 8 * 8;
    constexpr int CV_P0UP = 2 * NI_UP, CV_P0 = 2 * NI_UP + NI_DN, CV_N0 = 2 * NI_UP + NI_DN + NI_WOUT, CV_N1A = NI_WIN + 2 * NI_UP + NI_DN, CV_N1B = 2 * (2 * NI_UP + NI_DN) + 4 * NI_POOL;
#define CONVERT_ITEM(IT) do { int r = (IT); int kind = -1, m8 = 0, fd = 0; \
        if (r < 2 * NI_UP) { kind = 0; m8 = r / NI_UP; r %= NI_UP; } else { r -= 2 * NI_UP; \
        if (r < NI_DN) { kind = 1; fd = 0; } else { r -= NI_DN; \
        if (r < NI_WOUT) { kind = 3; } else { r -= NI_WOUT; \
        if (r < NI_WIN) { kind = 2; } else { r -= NI_WIN; \
        if (r < 2 * NI_UP) { kind = 0; m8 = 4 + r / NI_UP; r %= NI_UP; } else { r -= 2 * NI_UP; \
        if (r < NI_DN) { kind = 1; fd = 2; } else { r -= NI_DN; \
        if (r < 2 * NI_UP) { kind = 0; m8 = 2 + r / NI_UP; r %= NI_UP; } else { r -= 2 * NI_UP; \
        if (r < NI_DN) { kind = 1; fd = 1; } else { r -= NI_DN; \
        if (r < 2 * NI_UP) { kind = 0; m8 = 6 + r / NI_UP; r %= NI_UP; } else { r -= 2 * NI_UP; \
        if (r < NI_DN) { kind = 1; fd = 3; } else { r -= NI_DN; kind = 4; } } } } } } } } } } \
        if (kind == 0) { const int f = m8 >> 1, half = m8 & 1, kb = r / 88, nb = r % 88, n0 = nb * 64, n = n0 + F.lane, dr = (n >> 7) * 256 + half * 128 + (n & 127); \
            const float* src = args.in[(f & 1) ? (half ? I_F2W3 : I_F2W1) : (half ? I_F1W3 : I_F1W1)] + (size_t)(f >> 1) * DM * DFF; \
            if (F8_UP) conv_item8(src, DFF, (unsigned char*)(Wup + f * UPSZ), DM, kb * 64, n0, dr, pg8::F8S_WUP, F.lane); \
            else conv_item(src, DFF, Wup + f * UPSZ, DM, kb * 64, n0, dr, F.lane); } \
        else if (kind == 1) { const int kb = r / 32, nb = r % 32; const float* src = args.in[(fd & 1) ? I_F2W2 : I_F1W2] + (size_t)(fd >> 1) * DFF * DM; \
            if (F8_DN) conv_item8(src, DM, (unsigned char*)(Wdn + fd * DNSZ), DFF, kb * 64, nb * 64, nb * 64 + F.lane, pg8::F8S_WDN, F.lane); \
            else conv_item(src, DM, Wdn + fd * DNSZ, DFF, kb * 64, nb * 64, nb * 64 + F.lane, F.lane); } \
        else if (kind == 2) { const int kb = r / 112, nb = r % 112, n0 = nb * 64, n = n0 + F.lane; int dr = n; \
            if (n0 < 2048) { const int tile = n >> 8, hsel = (n >> 7) & 1, jj = n & 127, bj = jj >> 6, j = jj & 63; dr = tile * 256 + bj * 128 + hsel * 64 + j; } \
            conv_item(args.in[I_WIN], NPROJ, Win, DM, kb * 64, n0, dr, F.lane); } \
        else if (kind == 3) { const int kb = r / 32, nb = r % 32; conv_item(args.in[I_WOUT], DM, Wout, DM, kb * 64, nb * 64, nb * 64 + F.lane, F.lane); } \
        else { const int g = r / NI_POOL, item = r % NI_POOL, kb = item / 8, nb = item % 8; \
            conv_item(args.in[I_POOLW] + (size_t)g * 512 * 512, 512, Wpool + (size_t)g * 512 * 512, 512, kb * 64, nb * 64, nb * 64 + F.lane, F.lane); } } while (0)
#define CONVERT_IN_TAIL(LO, N) do { if (blockIdx.x >= 32) { const int wk_ = ((int)blockIdx.x - 32) * NWAVES + F.wave, nwk_ = (F.G - 32) * NWAVES; \
        for (int it_ = wk_; it_ < (N); it_ += nwk_) CONVERT_ITEM((LO) + it_); } __syncthreads(); } while (0)

#define BUILD_SC() do { LAS float* SC_ = (LAS float*)(F.lds + 8 * 8704); \
        for (int i = F.tid; i < 5 * DM; i += NTHR) { const int r = i / DM, k = i % DM; const float cv = r < 4 ? args.in[I_C][r * DM + k] : args.in[I_CCTX][k]; SC_[i] = cv / (1.0f + expf(-cv)); } \
        __syncthreads(); } while (0)
#define GEMV_ITEM(LAYER, REM) do { const LAS float* SC_ = (const LAS float*)(F.lds + 8 * 8704); const int layer_ = (LAYER), ks_ = (REM) / 72, cb_ = (REM) % 72, col_ = cb_ * 256 + 4 * F.lane; \
        const float* wp_ = args.in[I_WMOD] + ((size_t)layer_ * DM + ks_ * 128) * MODW + col_; \
        f32x4 a0 = {0, 0, 0, 0}, a1 = a0, a2 = a0, a3 = a0, a4 = a0; \
        _Pragma("unroll 1") for (int kb_ = 0; kb_ < 128; kb_ += GV_ROWS) { f32x4 w_[GV_ROWS]; \
            _Pragma("unroll") for (int q_ = 0; q_ < GV_ROWS; ++q_) w_[q_] = __builtin_nontemporal_load((const GAS f32x4*)(wp_ + (size_t)(kb_ + q_) * MODW)); \
            __builtin_amdgcn_sched_barrier(0); \
            _Pragma("unroll") for (int g_ = 0; g_ < GV_ROWS / 8; ++g_) { \
                _Pragma("unroll") for (int q_ = 8 * g_; q_ < 8 * g_ + 8; ++q_) { const int kk = ks_ * 128 + kb_ + q_; \
                    a0 += w_[q_] * SC_[kk]; a1 += w_[q_] * SC_[DM + kk]; a2 += w_[q_] * SC_[2 * DM + kk]; a3 += w_[q_] * SC_[3 * DM + kk]; a4 += w_[q_] * SC_[4 * DM + kk]; } \
                __builtin_amdgcn_sched_barrier(0); } } \
        float* op_ = modp + ((size_t)((ks_ * 2 + layer_) * 5)) * MODW + col_; \
        *(f32x4*)(op_) = a0; *(f32x4*)(op_ + MODW) = a1; *(f32x4*)(op_ + 2 * MODW) = a2; *(f32x4*)(op_ + 3 * MODW) = a3; *(f32x4*)(op_ + 4 * MODW) = a4; } while (0)
    constexpr int GV_ROWS = 32, P2_WIN = 2500;
    constexpr int GV_P0 = KS_MOD * 24, GV_P3 = KS_MOD * 48;
    constexpr int GV_L = KS_MOD * 72, GV_P2 = GV_L / 2;

    if (IN(0)) REP(0) {
#define A3_BLOCK() \
        { \
            LAS float* WL = (LAS float*)F.lds; \
            for (int i = F.tid; i < 33 * 64; i += NTHR) WL[i] = args.in[I_FW1][i]; \
            for (int i = F.tid; i < 64 * 64; i += NTHR) { WL[2112 + i] = args.in[I_FW2][i]; WL[2112 + 4096 + i] = args.in[I_FW3][i]; } \
            __syncthreads(); \
            const int l = F.lane; \
            const float b1 = args.in[I_FB1][l], b2 = args.in[I_FB2][l], b3 = args.in[I_FB3][l], f1 = args.in[I_FREQ][l], f2 = args.in[I_FREQ][64 + l], f3 = args.in[I_FREQ][128 + l]; \
            for (int t = F.gw; t < SEQ; t += F.NGW) { \
                float z = 0.f; \
                { const float w = 6.283185307179586f * (float)t / 4096.0f; \
                  if (l == 0) z = (float)t / 4095.0f; \
                  else if (l <= 16) { const float f = 1e-4f + (float)(l - 1) * ((15.0f - 1e-4f) / 15.0f); z = cosf(f * w); } \
                  else if (l <= 32) { const float f = 1e-4f + (float)(l - 17) * ((15.0f - 1e-4f) / 15.0f); z = -sinf(f * w); } } \
                float s = b1; \
_Pragma("unroll") \
                for (int i = 0; i < 33; ++i) s += __shfl(z, i) * WL[i * 64 + l]; \
                float a = sinf(f1 * s); \
                s = b2; \
_Pragma("unroll 16") \
                for (int i = 0; i < 64; ++i) s += __shfl(a, i) * WL[2112 + i * 64 + l]; \
                a = sinf(f2 * s); \
                s = b3; \
_Pragma("unroll 16") \
                for (int i = 0; i < 64; ++i) s += __shfl(a, i) * WL[2112 + 4096 + i * 64 + l]; \
                a = sinf(f3 * s); \
                A3[t * 64 + l] = a; \
            } \
            __syncthreads(); \
        }
        const bool a3_first = (blockIdx.x & 1) == 0;
        if (a3_first) A3_BLOCK()
        BUILD_SC();
        const int pw = F.wave * F.G + (int)blockIdx.x;
        if (F.NGW > GV_L) { if (pw < GV_P0) GEMV_ITEM(0, (pw / 24) * 72 + pw % 24); } else for (int it_ = pw; it_ < GV_P0; it_ += F.NGW) GEMV_ITEM(0, (it_ / 24) * 72 + it_ % 24);
        for (int i = blockIdx.x * NTHR + F.tid; i < SEQ * 64; i += F.G * NTHR) {
            const int t = i >> 6, j = i & 63; const float pos = (float)(j < 32 ? (t >> 6) : (t & 63));
            const float inv = powf(10000.0f, -(float)(j & 31) / 32.0f); const float ang = pos * inv;
            rotc[i] = cosf(ang); rots[i] = sinf(ang);
        }
        if (F.NGW > GV_L) { if (pw >= GV_P0) for (int it_ = pw - GV_P0; it_ < CV_P0UP; it_ += F.NGW - GV_P0) CONVERT_ITEM(it_); }
        else for (int it_ = pw; it_ < CV_P0UP; it_ += F.NGW) CONVERT_ITEM(it_);
        if (!a3_first) { __syncthreads(); A3_BLOCK() }
        __syncthreads();
    }
    SEAM(0);

    if (IN(1)) REP(1) {
        for (int i = blockIdx.x * NTHR + F.tid; i < 5 * MODW / 4; i += F.G * NTHR) {
            const int e = i * 4, layer = e / (5 * MODW), r = (e / MODW) % 5, col = e % MODW;
            if (col < 3 * DM) *(f32x4*)(mod + e) = mod_from_partials(modp, args.in[I_BMOD], layer, r, col);
        }
        norm_pass(F, args.in[I_X], args.in[I_CTX], MA, nullptr, modp, args.in[I_BMOD], 0, 0, HN, F8_UP);
    }
    SEAM(1);

#define FFN_UP(f, MROWS) do { constexpr int KE = F8_UP ? DM / 2 : DM; pg8::Gemm g{KE, KE, KE}; pg8::StaticOrder S; S.init(HN, Wup + (size_t)(f) * UPSZ, (MROWS), NUP, KE, KE, F.G, (int)blockIdx.x); \
        pg8::EpiSwiglu<F8_DN != 0> E{HID, F8_DN ? DFF : DFF, F8_UP ? 1.0f / (pg8::F8S_ACT * pg8::F8S_WUP) : 1.0f}; pg8::gemm_phase<pg8::EpiSwiglu<F8_DN != 0>, pg8::StaticOrder, true, true, F8_UP != 0>(F.lds, g, S, E); } while (0)
#define FFN_DN(f, MROWS, BF32_, BL, BC, LAYER, J) do { constexpr int KE = F8_DN ? DFF / 2 : DFF; pg8::Gemm g{KE, KE, KE}; pg8::StaticOrder S; S.init(HID, Wdn + (size_t)(f) * DNSZ, (MROWS), DM, KE, KE, F.G, (int)blockIdx.x); \
        pg8::EpiResid<BF32_> E{(BL), (BC), (pg8::bf16_t*)XB, mod + ((size_t)((LAYER) * 5) * 9 + (J)) * DM, 9 * DM, nullptr, F8_DN ? 0.5f / (pg8::F8S_HID * pg8::F8S_WDN) : 0.5f}; pg8::gemm_phase<pg8::EpiResid<BF32_>, pg8::StaticOrder, true, true, F8_DN != 0>(F.lds, g, S, E); } while (0)

    if (IN(2)) REP(2) { FFN_UP(0, MA);
        const int nun_ = (MA / 256) * (NUP / 256), fi_ = nun_ % F.G, nidle_ = fi_ ? F.G - fi_ : F.G, widx_ = fi_ ? (int)blockIdx.x - fi_ : (int)blockIdx.x;
        if (widx_ >= 0) { BUILD_SC(); for (int it_ = F.wave * nidle_ + widx_; it_ < GV_P2; it_ += nidle_ * NWAVES) GEMV_ITEM(1, it_);
            for (int it_ = F.wave * nidle_ + widx_; it_ < NI_DN; it_ += nidle_ * NWAVES) CONVERT_ITEM(CV_P0UP + it_);
            for (int it_ = F.wave * nidle_ + widx_; it_ < P2_WIN; it_ += nidle_ * NWAVES) CONVERT_ITEM(CV_N0 + it_);
            __syncthreads(); }
    }
    SEAM(2);
    if (IN(3)) { FFN_DN(0, MA, true, args.in[I_X], args.in[I_CTX], 0, 2);
        LAS float* W4T = (LAS float*)F.lds;
        for (int it = (int)blockIdx.x - 32; it >= 0 && it < 512; it += F.G - 32) {
            const int tb = it >> 6, cb = it & 63, t = tb * 512 + F.tid;
            __syncthreads();
            for (int i = F.tid; i < 4096; i += NTHR) { const int k = i >> 6, c = i & 63; W4T[c * 64 + k] = args.in[I_FW4][(size_t)k * 4096 + cb * 64 + c]; }
            typedef float f32x2_ __attribute__((ext_vector_type(2)));
            f32x2_ a2[32];
#pragma unroll
            for (int q = 0; q < 16; ++q) { const f32x4 v = *(const f32x4*)(A3 + (size_t)t * 64 + 4 * q); a2[2 * q] = (f32x2_){v.x, v.y}; a2[2 * q + 1] = (f32x2_){v.z, v.w}; }
            __syncthreads();
            const float tn = (float)t / 4095.0f;
#pragma unroll 2
            for (int c = 0; c < 64; ++c) {
                f32x2_ sa = {0.f, 0.f}, sb = {0.f, 0.f};
#pragma unroll
                for (int q = 0; q < 16; ++q) { const f32x4 w = *(const LAS f32x4*)(W4T + c * 64 + 4 * q); sa += a2[2 * q] * (f32x2_){w.x, w.y}; sb += a2[2 * q + 1] * (f32x2_){w.z, w.w}; }
                const float s = (sa.x + sa.y) + (sb.x + sb.y);
                const int col = cb * 64 + c, o = col >> 11, side = (col >> 10) & 1, ch = col & 1023;
                const float mind = -3.0701134573253945f, maxd = -15.350567286626973f;
                const float delta = fabsf(mind + (float)ch * ((maxd - mind) / 1023.0f));
                const float val = s * expf(-tn * delta);
                bf16* kr = KR + ((size_t)(o * 1024 + ch)) * 8192;
                if (side == 0) kr[4096 - t] = (bf16)f2bf(val);
                else kr[t == 0 ? 0 : 4096 + t] = (bf16)f2bf(t == 0 ? 0.0f : val);
            }
        }
        __syncthreads();
        if (blockIdx.x >= 32) { constexpr int LO_ = CV_N0 + P2_WIN, N_ = CV_N1A - P2_WIN;
            const int nw_ = F.G - 32, wgi_ = (int)blockIdx.x - 32, krx_ = nw_ < 512 ? 512 % nw_ : 0, nb_ = (nw_ - krx_) * NWAVES;
            BUILD_SC();
            const int ngv_ = nb_ >= GV_P3 ? GV_P3 : 0, nb2_ = nb_ - ngv_, nng_ = krx_ * NWAVES + nb2_;
            int pre_ = 4 * nb2_, pre2_ = pre_ + nng_; if (pre2_ > N_) { pre_ = 0; pre2_ = 0; }
            if (wgi_ >= krx_) { const int wb_ = (wgi_ - krx_) + (nw_ - krx_) * F.wave;
                if (wb_ < ngv_) GEMV_ITEM(0, (wb_ / 48) * 72 + 24 + wb_ % 48);
                else if (pre2_ > 0) { for (int j_ = 0; j_ < 4; ++j_) CONVERT_ITEM(LO_ + (wb_ - ngv_) + j_ * nb2_); CONVERT_ITEM(LO_ + pre_ + krx_ * NWAVES + (wb_ - ngv_)); } }
            else if (pre2_ > 0) CONVERT_ITEM(LO_ + pre_ + wgi_ + krx_ * F.wave);
            if (ngv_ == 0) for (int it_ = wgi_ + nw_ * F.wave; it_ < GV_P3; it_ += nw_ * NWAVES) GEMV_ITEM(0, (it_ / 48) * 72 + 24 + it_ % 48);
            for (int it_ = pre2_ + wgi_ + nw_ * F.wave; it_ < N_; it_ += nw_ * NWAVES) CONVERT_ITEM(LO_ + it_); }
        __syncthreads();
    }
    SEAM(3);
    if (IN(4)) REP(4) {
        int i0_ = blockIdx.x * NTHR + F.tid; asm volatile("" : "+v"(i0_));
        for (int i = i0_; i < 5 * MODW / 4; i += F.G * NTHR) {
            const int e = i * 4, r = e / MODW, col = e % MODW;
            if (col >= 3 * DM) *(f32x4*)(mod + e) = mod_from_partials(modp, args.in[I_BMOD], 0, r, col);
        }
        norm_pass_h(F, XB, MA, mod, 0, 3, HN, false, modp, args.in[I_BMOD]);
    }
    SEAM(4);
    if (IN(5)) REP(5) {
        struct WinOrder {
            int G, c; const char* HN; const char* Win;
            __device__ __forceinline__ bool next(int i, pg8::Unit& u) const {
                const int L = i * G + c; const size_t ps = (size_t)256 * DM * 2;
                if (L < 1024) { pg8::tile_of(L, 64, 16, u.pm, u.pn); u.A = HN + u.pm * ps; u.B = Win + u.pn * ps; u.ty = u.pn < 4 ? 0 : (u.pn < 8 ? 1 : (u.pn < 12 ? 2 : 3)); return true; }
                if (L < 1792) { pg8::tile_of(L - 1024, 12, 64, u.pm, u.pn); u.A = Win + (size_t)(16 + u.pm) * ps; u.B = HN + u.pn * ps; u.ty = 4; return true; }
                if (L < 1824) { pg8::tile_of(L - 1792, 4, 8, u.pm, u.pn); u.A = HN + (size_t)(64 + u.pm) * ps; u.B = Win + (size_t)(4 + u.pn) * ps; u.ty = 5; return true; }
                return false;
            }
        } S{F.G, (int)blockIdx.x, (const char*)HN, (const char*)Win};
        pg8::Gemm g{DM, DM, DM};
        pg8::EpiWin E{ws, rotc, rots};
        pg8::gemm_phase<pg8::EpiWin, WinOrder, true, true>(F.lds, g, S, E);
        if (blockIdx.x >= 32) { BUILD_SC();
            const int nwg_ = F.G - 32, wk_ = F.wave * nwg_ + ((int)blockIdx.x - 32), nwk_ = nwg_ * NWAVES, ng_ = GV_L - GV_P2;
            constexpr int NV_ = NI_WOUT + CV_N1B;
#define P5_ITEM(V) do { const int v_ = (V); if (v_ < NI_WOUT) CONVERT_ITEM(CV_P0 + v_); else CONVERT_ITEM(CV_N0 + CV_N1A + (v_ - NI_WOUT)); } while (0)
            if (nwk_ > ng_) { const int pre_ = 8 * (nwk_ - ng_);
                if (wk_ < ng_) GEMV_ITEM(1, GV_P2 + wk_); else for (int j_ = 0; j_ < 8; ++j_) P5_ITEM((wk_ - ng_) + j_ * (nwk_ - ng_));
                for (int it_ = pre_ + wk_; it_ < NV_; it_ += nwk_) P5_ITEM(it_); }
            else { for (int it_ = wk_; it_ < ng_; it_ += nwk_) GEMV_ITEM(1, GV_P2 + it_); for (int it_ = wk_; it_ < NV_; it_ += nwk_) P5_ITEM(it_); }
#undef P5_ITEM
        }
        __syncthreads();
    }
    SEAM(5);

    if (IN(6)) REP(6) {
        for (int un0 = blockIdx.x; un0 < 256; un0 += F.G) {
            const int un = (F.G == 256) ? (((un0 & 7) * 4 + (un0 >> 6)) * 8 + ((un0 >> 3) & 7)) : un0;
            const int bh = un >> 3, dir = (un >> 2) & 1, es = un & 3, b = bh >> 3, h = bh & 7;
            const float lg = args.in[I_LOGD][dir * 8 + h];
            const float cdec = fexp(128.0f * lg);
            constexpr int SC_K = 128 * 272, SC_V = 128 * 80, SC_SET = SC_K + SC_V;
            f32x4 acc[2] = {(f32x4){0, 0, 0, 0}, (f32x4){0, 0, 0, 0}};
            const int g4 = F.lane >> 4, q4 = (F.lane & 15) >> 2, p4 = F.lane & 3;
            v4u kraw[2][4], vraw[2];
#define SCAN_PTRS(step_) int cidx; bool isctx; if (dir == 0) { isctx = (step_) < 2; cidx = isctx ? (step_) : (step_) - 2; } else { isctx = (step_) < 2; cidx = isctx ? 1 - (step_) : 33 - (step_); } \
                const bf16* kp; const bf16* vp; int ld; if (isctx) { kp = KVC + (size_t)(b * CTXL + cidx * 128) * 2048 + h * 128; vp = kp + 1024; ld = 2048; } else { kp = QKVG + (size_t)(b * SEQ + cidx * 128) * 4096 + 1024 + h * 128; vp = kp + 1024; ld = 4096; }
#define SCAN_FETCH(S_) do { _Pragma("unroll") for (int i = 0; i < 4; ++i) { const int id = F.tid + NTHR * i, j = id >> 4, c8 = id & 15; kraw[S_][i] = *(const GAS v4u*)(kp + (size_t)j * ld + c8 * 8); } \
                { const int j = F.tid >> 2, c8 = F.tid & 3; vraw[S_] = *(const GAS v4u*)(vp + (size_t)j * ld + es * 32 + c8 * 8); } } while (0)
            { SCAN_PTRS(0); SCAN_FETCH(0); } { SCAN_PTRS(1); SCAN_FETCH(1); }
            for (int it = 0; it < 17; ++it) {
                LDS_BARRIER();
#pragma unroll
                for (int S_ = 0; S_ < 2; ++S_) {
#pragma unroll
                    for (int i = 0; i < 4; ++i) { const int id = F.tid + NTHR * i, j = id >> 4, c8 = id & 15; const v4u raw = kraw[S_][i];
                        const float kd = fexp(lg * (float)(dir == 0 ? 127 - j : j));
                        v4u o; o.x = pk2(bflo(raw.x) * kd, bfhi(raw.x) * kd); o.y = pk2(bflo(raw.y) * kd, bfhi(raw.y) * kd); o.z = pk2(bflo(raw.z) * kd, bfhi(raw.z) * kd); o.w = pk2(bflo(raw.w) * kd, bfhi(raw.w) * kd);
                        *(LAS v4u*)(F.lds + S_ * SC_SET + j * 272 + c8 * 16) = o; }
                    { const int j = F.tid >> 2, c8 = F.tid & 3; *(LAS v4u*)(F.lds + S_ * SC_SET + SC_K + j * 80 + c8 * 16) = vraw[S_]; } }
                if (it + 1 < 17) { { SCAN_PTRS(2 * it + 2); SCAN_FETCH(0); } { SCAN_PTRS(2 * it + 3); SCAN_FETCH(1); } }
                LDS_BARRIER();
                f32x4 u[2][2];
#pragma unroll
                for (int S_ = 0; S_ < 2; ++S_) { u[S_][0] = (f32x4){0, 0, 0, 0}; u[S_][1] = (f32x4){0, 0, 0, 0};
                    LAS unsigned char* KL = F.lds + S_ * SC_SET; LAS unsigned char* VL = KL + SC_K;
#pragma unroll
                    for (int ks = 0; ks < 4; ++ks) {
                        const s16x4 a0 = __builtin_amdgcn_ds_read_tr16_b64_v4i16((LAS s16x4*)(KL + (32 * ks + 8 * g4 + q4) * 272 + (16 * F.wave + 4 * p4) * 2));
                        const s16x4 a1 = __builtin_amdgcn_ds_read_tr16_b64_v4i16((LAS s16x4*)(KL + (32 * ks + 8 * g4 + 4 + q4) * 272 + (16 * F.wave + 4 * p4) * 2));
                        bf16x8 af; af[0] = a0[0]; af[1] = a0[1]; af[2] = a0[2]; af[3] = a0[3]; af[4] = a1[0]; af[5] = a1[1]; af[6] = a1[2]; af[7] = a1[3];
#pragma unroll
                        for (int c = 0; c < 2; ++c) {
                            const s16x4 b0 = __builtin_amdgcn_ds_read_tr16_b64_v4i16((LAS s16x4*)(VL + (32 * ks + 8 * g4 + q4) * 80 + (16 * c + 4 * p4) * 2));
                            const s16x4 b1 = __builtin_amdgcn_ds_read_tr16_b64_v4i16((LAS s16x4*)(VL + (32 * ks + 8 * g4 + 4 + q4) * 80 + (16 * c + 4 * p4) * 2));
                            bf16x8 bfr; bfr[0] = b0[0]; bfr[1] = b0[1]; bfr[2] = b0[2]; bfr[3] = b0[3]; bfr[4] = b1[0]; bfr[5] = b1[1]; bfr[6] = b1[2]; bfr[7] = b1[3];
                            u[S_][c] = __builtin_amdgcn_mfma_f32_16x16x32_bf16(af, bfr, u[S_][c], 0, 0, 0);
                        }
                    } }
#pragma unroll
                for (int S_ = 0; S_ < 2; ++S_) {
                    SCAN_PTRS(2 * it + S_);
                    if (!isctx) {
                        bf16* sp = SPREV + ((size_t)((bh * 2 + dir) * 32 + cidx)) * 16384;
#pragma unroll
                        for (int c = 0; c < 2; ++c)
#pragma unroll
                            for (int r = 0; r < 4; ++r) sp[(size_t)(16 * F.wave + 4 * g4 + r) * 128 + es * 32 + 16 * c + (F.lane & 15)] = (bf16)f2bf(acc[c][r]);
                    }
                    acc[0] = acc[0] * cdec + u[S_][0]; acc[1] = acc[1] * cdec + u[S_][1];
                }
            }
            LDS_BARRIER();
        }
#undef SCAN_PTRS
#undef SCAN_FETCH
#if HY_NAIVE
        for (int ch = blockIdx.x; ch < 1024; ch += F.G) {
            LAS float* Kf = (LAS float*)F.lds;
            LAS float* U = (LAS float*)(F.lds + 32768);
            const float* cw = args.in[I_CONVW]; const float* cb = args.in[I_CONVB];
            float acc[8][4];
            for (int cv = 0; cv < 2; ++cv) {
                __syncthreads();
                for (int i = F.tid; i < 8192; i += NTHR) Kf[i] = bf2f(KR[((size_t)(cv * 1024 + ch)) * 8192 + i]);
                if (cv == 0) {
                    const float w0 = cw[ch], w1 = cw[3072 + ch], w2 = cw[6144 + ch], bb = cb[ch];
                    for (int i = F.tid; i < 16384; i += NTHR) { const int b = i >> 12, t = i & 4095; const bf16* p = PHT + (size_t)ch * 16384 + i;
                        const float pm = t > 0 ? bf2f(p[-1]) : 0.f, p0 = bf2f(p[0]), pp = t < 4095 ? bf2f(p[1]) : 0.f;
                        U[t * 4 + b] = bb + pm * w0 + p0 * w1 + pp * w2; }
                } else {
                    const int c1 = 1024 + ch; const float w0 = cw[c1], w1 = cw[3072 + c1], w2 = cw[6144 + c1], bb = cb[c1], hb = args.in[I_HYB][ch];
#pragma unroll
                    for (int i = 0; i < 8; ++i)
#pragma unroll
                        for (int b = 0; b < 4; ++b) { const int t = F.tid + NTHR * i; const bf16* p = PHT + (size_t)c1 * 16384 + b * 4096 + t;
                            const float pm = t > 0 ? bf2f(p[-1]) : 0.f, p0 = bf2f(p[0]), pp = t < 4095 ? bf2f(p[1]) : 0.f;
                            const float x1 = bb + pm * w0 + p0 * w1 + pp * w2;
                            acc[i][b] = x1 * (acc[i][b] + hb * U[t * 4 + b]); }
                    __syncthreads();
#pragma unroll
                    for (int i = 0; i < 8; ++i)
#pragma unroll
                        for (int b = 0; b < 4; ++b) U[(F.tid + NTHR * i) * 4 + b] = acc[i][b];
                }
                __syncthreads();
                float a[8][4];
#pragma unroll
                for (int i = 0; i < 8; ++i)
#pragma unroll
                    for (int b = 0; b < 4; ++b) a[i][b] = 0.f;
                for (int s = 0; s < 4096; ++s) {
                    const f32x4 u = *(const LAS f32x4*)(U + s * 4);
#pragma unroll
                    for (int i = 0; i < 8; ++i) { const float kv = Kf[4096 - (F.tid + NTHR * i) + s]; a[i][0] += kv * u.x; a[i][1] += kv * u.y; a[i][2] += kv * u.z; a[i][3] += kv * u.w; }
                }
#pragma unroll
                for (int i = 0; i < 8; ++i)
#pragma unroll
                    for (int b = 0; b < 4; ++b) acc[i][b] = a[i][b];
            }
            { const int c2 = 2048 + ch; const float w0 = cw[c2], w1 = cw[3072 + c2], w2 = cw[6144 + c2], bb = cb[c2], hb = args.in[I_HYB][1024 + ch];
#pragma unroll
              for (int i = 0; i < 8; ++i)
#pragma unroll
                  for (int b = 0; b < 4; ++b) { const int t = F.tid + NTHR * i; const bf16* p = PHT + (size_t)c2 * 16384 + b * 4096 + t;
                      const float pm = t > 0 ? bf2f(p[-1]) : 0.f, p0 = bf2f(p[0]), pp = t < 4095 ? bf2f(p[1]) : 0.f;
                      const float x2 = bb + pm * w0 + p0 * w1 + pp * w2;
                      YHT[(size_t)ch * 16384 + b * 4096 + t] = (bf16)f2bf(x2 * (acc[i][b] + hb * U[t * 4 + b])); } }
            __syncthreads();
        }
#else
        {
            constexpr int HY_CP = 16448, HY_U = 4 * HY_CP, HY_UB = 4608 * 2, HY_X = HY_U + 4 * HY_UB;
            const float* cw = args.in[I_CONVW]; const float* cb = args.in[I_CONVB];
            const int l15 = F.lane & 15, g4 = F.lane >> 4, tau0 = 2 * F.wave;
            const int sg = (-l15) & 3, ci4 = (l15 + 3) >> 2;
            const int mlo = -(8 * tau0 + 8);
            const unsigned a_base = (unsigned)(sg * HY_CP + 2 * (4096 + 16 + 32 * mlo + 8 * g4 - 4 * ci4));
            const unsigned b_base = (unsigned)(HY_U + 2 * (256 + 256 * tau0 + 16 * l15 + 32 * mlo + 8 * g4));
            v4u tp[3]; v4u ra[4], rb[4]; unsigned ral[4], rar[4], rbl[4], rbr[4]; float wa[4], wb[4], hb0 = 0.f, hb1 = 0.f;
#define HY_PF_TAPS(KRP) do { _Pragma("unroll") for (int i_ = 0; i_ < 3; ++i_) { const int c_ = F.tid + NTHR * i_, x0_ = 8 * c_ - 16; tp[i_] = (v4u){0u, 0u, 0u, 0u}; \
                if (c_ < 1028 && x0_ >= 0 && x0_ < 8192) tp[i_] = *(const GAS v4u*)((KRP) + x0_); } } while (0)
#define HY_WR_TAPS() do { _Pragma("unroll") for (int i_ = 0; i_ < 3; ++i_) { const int c_ = F.tid + NTHR * i_; if (c_ < 1028) *(LAS v4u*)(F.lds + c_ * 16) = tp[i_]; } } while (0)
#define HY_PF_ROW(R_, RL_, RR_, W_, CC) do { const unsigned short* prow_ = (const unsigned short*)(PHT + (size_t)(CC) * 16384); W_[0] = cw[(CC)]; W_[1] = cw[3072 + (CC)]; W_[2] = cw[6144 + (CC)]; W_[3] = cb[(CC)]; \
                _Pragma("unroll") for (int it = 0; it < 4; ++it) { const int id = F.tid + NTHR * it, b = id >> 9, t0 = (id & 511) * 8; const unsigned short* p = prow_ + b * 4096 + t0; \
                    R_[it] = *(const GAS v4u*)p; RL_[it] = t0 > 0 ? (unsigned)p[-1] : 0u; RR_[it] = t0 < 4088 ? (unsigned)p[8] : 0u; } } while (0)
#define HY_WR_ROW(R_, RL_, RR_, W_, TO_U) do { const float w0 = W_[0], w1 = W_[1], w2 = W_[2], bb = W_[3]; \
                _Pragma("unroll") for (int it = 0; it < 4; ++it) { const int id = F.tid + NTHR * it, b = id >> 9, t0 = (id & 511) * 8; const v4u raw = R_[it]; \
                    const float x[10] = {bf2f((unsigned short)RL_[it]), bflo(raw.x), bfhi(raw.x), bflo(raw.y), bfhi(raw.y), bflo(raw.z), bfhi(raw.z), bflo(raw.w), bfhi(raw.w), bf2f((unsigned short)RR_[it])}; \
                    float o[8]; _Pragma("unroll") for (int e = 0; e < 8; ++e) o[e] = bb + x[e] * w0 + x[e + 1] * w1 + x[e + 2] * w2; \
                    v4u ov; ov.x = pk2(o[0], o[1]); ov.y = pk2(o[2], o[3]); ov.z = pk2(o[4], o[5]); ov.w = pk2(o[6], o[7]); \
                    if (TO_U) *(LAS v4u*)(F.lds + HY_U + b * HY_UB + (256 + t0) * 2) = ov; else *(LAS v4u*)(F.lds + HY_X + (b * 4096 + t0) * 2) = ov; } } while (0)
#define HY_COPIES() do { for (int w = F.tid; w < 2056; w += NTHR) { \
                const unsigned long long lo = *(const LAS unsigned long long*)(F.lds + w * 8), hi = (w < 2055) ? *(const LAS unsigned long long*)(F.lds + w * 8 + 8) : 0ull; \
                _Pragma("unroll") for (int sgm = 1; sgm < 4; ++sgm) *(LAS unsigned long long*)(F.lds + sgm * HY_CP + w * 8) = (lo >> (16 * sgm)) | (hi << (64 - 16 * sgm)); } } while (0)
#define HY_EPI(CV, CH, HB) do { const float hb = (HB); \
                _Pragma("unroll") for (int j = 0; j < 2; ++j) _Pragma("unroll") for (int b = 0; b < 4; ++b) { \
                    const int t = 256 * (tau0 + j) + 16 * l15 + 4 * g4; \
                    const v2u uv = *(const LAS v2u*)(F.lds + HY_U + b * HY_UB + (256 + t) * 2), xv = *(const LAS v2u*)(F.lds + HY_X + (b * 4096 + t) * 2); \
                    const float o0 = bflo(xv.x) * (acc[j][b][0] + hb * bflo(uv.x)), o1 = bfhi(xv.x) * (acc[j][b][1] + hb * bfhi(uv.x)); \
                    const float o2 = bflo(xv.y) * (acc[j][b][2] + hb * bflo(uv.y)), o3 = bfhi(xv.y) * (acc[j][b][3] + hb * bfhi(uv.y)); \
                    v2u ov; ov.x = pk2(o0, o1); ov.y = pk2(o2, o3); \
                    if ((CV) == 0) *(LAS v2u*)(F.lds + HY_U + b * HY_UB + (256 + t) * 2) = ov; \
                    else *(GAS v2u*)(YHT + (size_t)(CH) * 16384 + b * 4096 + t) = ov; } } while (0)
#define HY_LOAD(A0_, A1_, B_, aa_, ba_) do { const s16x4 a00_ = *(const volatile LAS s16x4*)(F.lds + (aa_)), a01_ = *(const volatile LAS s16x4*)(F.lds + (aa_) + 8), a10_ = *(const volatile LAS s16x4*)(F.lds + (aa_) - 512), a11_ = *(const volatile LAS s16x4*)(F.lds + (aa_) - 504);     \
                A0_ = __builtin_shufflevector(a00_, a01_, 0, 1, 2, 3, 4, 5, 6, 7); A1_ = __builtin_shufflevector(a10_, a11_, 0, 1, 2, 3, 4, 5, 6, 7); \
                _Pragma("unroll") for (int b = 0; b < 4; ++b) B_[b] = *(const LAS bf16x8*)(F.lds + (ba_) + b * HY_UB); } while (0)
#define HY_MMA(A0_, A1_, B_) do { _Pragma("unroll") for (int b = 0; b < 4; ++b) { acc[0][b] = __builtin_amdgcn_mfma_f32_16x16x32_bf16(A0_, B_[b], acc[0][b], 0, 0, 0); acc[1][b] = __builtin_amdgcn_mfma_f32_16x16x32_bf16(A1_, B_[b], acc[1][b], 0, 0, 0); } } while (0)
#define HY_LOOP() do { _Pragma("unroll") for (int j = 0; j < 2; ++j) _Pragma("unroll") for (int b = 0; b < 4; ++b) acc[j][b] = (f32x4){0.f, 0.f, 0.f, 0.f}; \
                bf16x8 XA0, XA1, XB[4], YA0, YA1, YB[4]; unsigned aa = a_base, ba = b_base; \
                HY_LOAD(XA0, XA1, XB, aa, ba); \
                for (int m = 0; m < 136; m += 2) { \
                    HY_LOAD(YA0, YA1, YB, aa + 64, ba + 64); __builtin_amdgcn_sched_barrier(0); \
                    HY_MMA(XA0, XA1, XB); __builtin_amdgcn_sched_barrier(0); \
                    if (m + 2 < 136) HY_LOAD(XA0, XA1, XB, aa + 128, ba + 128); \
                    __builtin_amdgcn_sched_barrier(0); \
                    HY_MMA(YA0, YA1, YB); __builtin_amdgcn_sched_barrier(0); \
                    aa += 128; ba += 128; } } while (0)
            f32x4 acc[2][4];
            int ch = blockIdx.x, chp = -1;
            if (ch < 1024) { HY_PF_TAPS(KR + (size_t)ch * 8192); HY_PF_ROW(ra, ral, rar, wa, ch); HY_PF_ROW(rb, rbl, rbr, wb, 1024 + ch); }
            for (; ch < 1024; ch += F.G) {
                LDS_BARRIER();
                if (chp >= 0) HY_EPI(1, chp, hb1);
                HY_WR_TAPS();
                LDS_BARRIER();
                if (F.tid < 256) { const int b = F.tid >> 6, q = F.tid & 63; const int off = (q < 32 ? q * 8 : 4352 + (q - 32) * 8); *(LAS v4u*)(F.lds + HY_U + b * HY_UB + off * 2) = (v4u){0u, 0u, 0u, 0u}; }
                HY_WR_ROW(ra, ral, rar, wa, true); HY_WR_ROW(rb, rbl, rbr, wb, false);
                HY_COPIES();
                hb0 = args.in[I_HYB][ch]; HY_PF_TAPS(KR + (size_t)(1024 + ch) * 8192); HY_PF_ROW(ra, ral, rar, wa, 2048 + ch);
                LDS_BARRIER();
                HY_LOOP();
                LDS_BARRIER();
                HY_EPI(0, ch, hb0);
                HY_WR_TAPS();
                LDS_BARRIER();
                HY_WR_ROW(ra, ral, rar, wa, false);
                HY_COPIES();
                hb1 = args.in[I_HYB][1024 + ch];
                if (ch + F.G < 1024) { const int chn = ch + F.G; HY_PF_TAPS(KR + (size_t)chn * 8192); HY_PF_ROW(ra, ral, rar, wa, chn); HY_PF_ROW(rb, rbl, rbr, wb, 1024 + chn); }
                LDS_BARRIER();
                HY_LOOP();
                chp = ch;
            }
            LDS_BARRIER();
            if (chp >= 0) HY_EPI(1, chp, hb1);
            LDS_BARRIER();
#undef HY_PF_TAPS
#undef HY_WR_TAPS
#undef HY_PF_ROW
#undef HY_WR_ROW
#undef HY_COPIES
#undef HY_EPI
#undef HY_LOAD
#undef HY_MMA
#undef HY_LOOP
        }
#endif
    }
    SEAM(6);

    if (IN(7)) REP(7) {
        constexpr int PT = 272;
        LAS unsigned char* QL = F.lds; LAS unsigned char* KL = F.lds + 128 * PT; LAS unsigned char* VL = F.lds + 2 * 128 * PT; LAS unsigned char* SL = F.lds + 3 * 128 * PT;
        const int g4 = F.lane >> 4, q4 = (F.lane & 15) >> 2, p4 = F.lane & 3, l15 = F.lane & 15, w = F.wave;
        v4u pq[4], pk[4], pv[4], ps[4], pb[4];
#define RO_FETCH_QK(UN) do { const int bh_ = (UN) >> 5, c_ = (UN) & 31; const bf16* qp_ = QKVG + ((size_t)(bh_ >> 3) * SEQ + c_ * 128) * 4096 + (bh_ & 7) * 128; \
            _Pragma("unroll") for (int i = 0; i < 4; ++i) { const int id = F.tid + NTHR * i, j = id >> 4, c8 = id & 15; \
                pq[i] = *(const GAS v4u*)(qp_ + (size_t)j * 4096 + c8 * 8); pk[i] = *(const GAS v4u*)(qp_ + (size_t)j * 4096 + 1024 + c8 * 8); } } while (0)
        if ((int)blockIdx.x < 1024) RO_FETCH_QK((int)blockIdx.x);
        for (int un = blockIdx.x; un < 1024; un += F.G) {
            const int bh = un >> 5, c = un & 31, b = bh >> 3, h = bh & 7;
            const float lgf = args.in[I_LOGD][h], lgb = args.in[I_LOGD][8 + h];
            const size_t row0 = (size_t)b * SEQ + c * 128;
            const bf16* qp = QKVG + row0 * 4096 + h * 128;
            LDS_BARRIER();
#pragma unroll
            for (int i = 0; i < 4; ++i) { const int id = F.tid + NTHR * i, j = id >> 4, c8 = id & 15; *(LAS v4u*)(QL + j * PT + c8 * 16) = pq[i]; *(LAS v4u*)(KL + j * PT + c8 * 16) = pk[i]; }
#pragma unroll
            for (int i = 0; i < 4; ++i) { const int id = F.tid + NTHR * i, j = id >> 4, c8 = id & 15;
                ps[i] = *(const GAS v4u*)(SPREV + ((size_t)((bh * 2 + 0) * 32 + c)) * 16384 + j * 128 + c8 * 8);
                pv[i] = *(const GAS v4u*)(qp + (size_t)j * 4096 + 2048 + c8 * 8); }
            if (un + F.G < 1024) RO_FETCH_QK(un + F.G);
            LDS_BARRIER();
            bf16x8 qf[4];
#pragma unroll
            for (int ks = 0; ks < 4; ++ks) qf[ks] = *(const LAS bf16x8*)(QL + (16 * w + l15) * PT + (32 * ks + 8 * g4) * 2);
            f32x4 sc[8];
#pragma unroll
            for (int jb = 0; jb < 8; ++jb) { sc[jb] = (f32x4){0, 0, 0, 0};
#pragma unroll
                for (int ks = 0; ks < 4; ++ks) { const bf16x8 kf = *(const LAS bf16x8*)(KL + (16 * jb + l15) * PT + (32 * ks + 8 * g4) * 2); sc[jb] = __builtin_amdgcn_mfma_f32_16x16x32_bf16(qf[ks], kf, sc[jb], 0, 0, 0); } }
#pragma unroll
            for (int i = 0; i < 4; ++i) { const int id = F.tid + NTHR * i, j = id >> 4, c8 = id & 15; *(LAS v4u*)(SL + j * PT + c8 * 16) = ps[i]; *(LAS v4u*)(VL + j * PT + c8 * 16) = pv[i]; }
            LDS_BARRIER();
            { int dbase = 16 * w + 4 * g4 - l15; asm volatile("" : "+v"(dbase));
#pragma unroll
              for (int jb = 0; jb < 8; ++jb)
#pragma unroll
                  for (int r = 0; r < 4; ++r) { const int i = 16 * w + 4 * g4 + r, j = 16 * jb + l15; const int df = dbase + r - 16 * jb;
                      const float dv = df > 0 ? fexp(lgf * (float)df) : (df < 0 ? fexp(lgb * (float)(-df)) : 2.0f);
                      *(LAS unsigned short*)(KL + i * PT + j * 2) = (unsigned short)f2bf(sc[jb][r] * dv); } }
#pragma unroll
            for (int i = 0; i < 4; ++i) { const int id = F.tid + NTHR * i, j = id >> 4, c8 = id & 15; pb[i] = *(const GAS v4u*)(SPREV + ((size_t)((bh * 2 + 1) * 32 + c)) * 16384 + j * 128 + c8 * 8); }
            f32x4 acc[8];
#pragma unroll
            for (int eb = 0; eb < 8; ++eb) { acc[eb] = (f32x4){0, 0, 0, 0};
#pragma unroll
                for (int ks = 0; ks < 4; ++ks) {
                    const s16x4 b0 = __builtin_amdgcn_ds_read_tr16_b64_v4i16((LAS s16x4*)(SL + (32 * ks + 8 * g4 + q4) * PT + (16 * eb + 4 * p4) * 2));
                    const s16x4 b1 = __builtin_amdgcn_ds_read_tr16_b64_v4i16((LAS s16x4*)(SL + (32 * ks + 8 * g4 + 4 + q4) * PT + (16 * eb + 4 * p4) * 2));
                    bf16x8 bfr; bfr[0] = b0[0]; bfr[1] = b0[1]; bfr[2] = b0[2]; bfr[3] = b0[3]; bfr[4] = b1[0]; bfr[5] = b1[1]; bfr[6] = b1[2]; bfr[7] = b1[3];
                    acc[eb] = __builtin_amdgcn_mfma_f32_16x16x32_bf16(qf[ks], bfr, acc[eb], 0, 0, 0); } }
            LDS_BARRIER();
#pragma unroll
            for (int i = 0; i < 4; ++i) { const int id = F.tid + NTHR * i, j = id >> 4, c8 = id & 15; *(LAS v4u*)(SL + j * PT + c8 * 16) = pb[i]; }
            float sfr[4], sbr[4];
#pragma unroll
            for (int r = 0; r < 4; ++r) { const int i = 16 * w + 4 * g4 + r; sfr[r] = fexp(lgf * (float)(i + 1)); sbr[r] = fexp(lgb * (float)(128 - i)); }
#pragma unroll
            for (int eb = 0; eb < 8; ++eb)
#pragma unroll
                for (int r = 0; r < 4; ++r) acc[eb][r] *= sfr[r] / sbr[r];
            LDS_BARRIER();
#pragma unroll
            for (int eb = 0; eb < 8; ++eb)
#pragma unroll
                for (int ks = 0; ks < 4; ++ks) {
                    const s16x4 b0 = __builtin_amdgcn_ds_read_tr16_b64_v4i16((LAS s16x4*)(SL + (32 * ks + 8 * g4 + q4) * PT + (16 * eb + 4 * p4) * 2));
                    const s16x4 b1 = __builtin_amdgcn_ds_read_tr16_b64_v4i16((LAS s16x4*)(SL + (32 * ks + 8 * g4 + 4 + q4) * PT + (16 * eb + 4 * p4) * 2));
                    bf16x8 bfr; bfr[0] = b0[0]; bfr[1] = b0[1]; bfr[2] = b0[2]; bfr[3] = b0[3]; bfr[4] = b1[0]; bfr[5] = b1[1]; bfr[6] = b1[2]; bfr[7] = b1[3];
                    acc[eb] = __builtin_amdgcn_mfma_f32_16x16x32_bf16(qf[ks], bfr, acc[eb], 0, 0, 0); }
#pragma unroll
            for (int eb = 0; eb < 8; ++eb)
#pragma unroll
                for (int r = 0; r < 4; ++r) acc[eb][r] *= sbr[r];
            bf16x8 pf[4];
#pragma unroll
            for (int ks = 0; ks < 4; ++ks) pf[ks] = *(const LAS bf16x8*)(KL + (16 * w + l15) * PT + (32 * ks + 8 * g4) * 2);
#pragma unroll
            for (int eb = 0; eb < 8; ++eb)
#pragma unroll
                for (int ks = 0; ks < 4; ++ks) {
                    const s16x4 b0 = __builtin_amdgcn_ds_read_tr16_b64_v4i16((LAS s16x4*)(VL + (32 * ks + 8 * g4 + q4) * PT + (16 * eb + 4 * p4) * 2));
                    const s16x4 b1 = __builtin_amdgcn_ds_read_tr16_b64_v4i16((LAS s16x4*)(VL + (32 * ks + 8 * g4 + 4 + q4) * PT + (16 * eb + 4 * p4) * 2));
                    bf16x8 bfr; bfr[0] = b0[0]; bfr[1] = b0[1]; bfr[2] = b0[2]; bfr[3] = b0[3]; bfr[4] = b1[0]; bfr[5] = b1[1]; bfr[6] = b1[2]; bfr[7] = b1[3];
                    acc[eb] = __builtin_amdgcn_mfma_f32_16x16x32_bf16(pf[ks], bfr, acc[eb], 0, 0, 0); }
#pragma unroll
            for (int r = 0; r < 4; ++r) {
                float s2 = 0.f;
#pragma unroll
                for (int eb = 0; eb < 8; ++eb) s2 += acc[eb][r] * acc[eb][r];
                s2 += __shfl_xor(s2, 1); s2 += __shfl_xor(s2, 2); s2 += __shfl_xor(s2, 4); s2 += __shfl_xor(s2, 8);
                const float rstd = 1.0f / sqrtf(s2 * (1.0f / 128.0f) + 1e-6f);
                const size_t row = row0 + 16 * w + 4 * g4 + r;
#pragma unroll
                for (int eb = 0; eb < 8; ++eb) { const int e = 16 * eb + l15; const float gv = bf2f(QKVG[row * 4096 + 3072 + h * 128 + e]);
                    A2[row * DM + h * 128 + e] = (bf16)f2bf(acc[eb][r] * rstd * gv); }
            }
        }
#undef RO_FETCH_QK
        __syncthreads();
        constexpr int TSZ = 64 * 72;
        LAS unsigned short* T = (LAS unsigned short*)F.lds;
        for (int it0 = blockIdx.x; it0 < 16 * 256; it0 += 8 * F.G) {
            v4u raw[8];
#pragma unroll
            for (int i = 0; i < 8; ++i) { const int it = it0 + i * F.G; if (it < 16 * 256) { const int cb = it >> 8, tb = it & 255, chl = F.tid >> 3, tk = F.tid & 7;
                raw[i] = *(const GAS v4u*)(YHT + (size_t)(cb * 64 + chl) * 16384 + tb * 64 + tk * 8); } }
            __syncthreads();
#pragma unroll
            for (int i = 0; i < 8; ++i) { const int it = it0 + i * F.G; if (it < 16 * 256) { const int chl = F.tid >> 3, tk = F.tid & 7; LAS unsigned short* Ti = T + i * TSZ;
                const unsigned wv[4] = {raw[i].x, raw[i].y, raw[i].z, raw[i].w};
#pragma unroll
                for (int x = 0; x < 4; ++x) { Ti[(tk * 8 + 2 * x) * 72 + chl] = (unsigned short)(wv[x] & 0xffffu); Ti[(tk * 8 + 2 * x + 1) * 72 + chl] = (unsigned short)(wv[x] >> 16); } } }
            __syncthreads();
#pragma unroll
            for (int i = 0; i < 8; ++i) { const int it = it0 + i * F.G; if (it < 16 * 256) { const int cb = it >> 8, tb = it & 255, tk = F.tid >> 3, ck = F.tid & 7;
                *(GAS v4u*)(A2 + (size_t)(tb * 64 + tk) * DM + 1024 + cb * 64 + ck * 8) = *(const LAS v4u*)(T + i * TSZ + tk * 72 + ck * 8); } }
        }
        __syncthreads();
    }
    SEAM(7);
    if (IN(8)) { pg8::Gemm g{DM, DM, DM}; pg8::StaticOrder S; S.init(A2, Wout, ML, DM, DM, DM, F.G, (int)blockIdx.x);
        pg8::EpiResid<false> E{XB, XB, (pg8::bf16_t*)XB, mod + ((size_t)(0 * 5) * 9 + 5) * DM, 9 * DM, nullptr, 1.0f}; pg8::gemm_phase<pg8::EpiResid<false>, pg8::StaticOrder, true, true>(F.lds, g, S, E); }
    SEAM(8);
    if (IN(9)) {
        for (int i = blockIdx.x * NTHR + F.tid; i < 5 * MODW / 4; i += F.G * NTHR) {
            const int e = i * 4, r = e / MODW, col = e % MODW;
            *(f32x4*)(mod + 5 * MODW + e) = mod_from_partials(modp, args.in[I_BMOD], 1, r, col);
        }
        norm_pass_h(F, XB, ML, mod, 0, 6, HN, F8_UP);
    }
    SEAM(9);
    if (IN(10)) REP(10) FFN_UP(1, ML);
    SEAM(10);
    if (IN(11)) FFN_DN(1, ML, false, XB, XB, 0, 8);
    SEAM(11);
    if (IN(12)) norm_pass_h(F, XB, ML, mod, 1, 0, HN, F8_UP);
    SEAM(12);
    if (IN(13)) FFN_UP(2, ML);
    SEAM(13);
    if (IN(14)) FFN_DN(2, ML, false, XB, XB, 1, 2);
    SEAM(14);
    if (IN(15)) norm_pass_h(F, XB, ML, mod, 1, 3, HN, false);
    SEAM(15);
    if (IN(16)) REP(16) {
        constexpr int PR = 2080;
        for (int un0 = blockIdx.x; un0 < 512; un0 += F.G) {
            int un = un0;
            if (F.G == 256) { const int w = un0 & 255, r = un0 >> 8, x = w & 7, y = w >> 3, j = x + 8 * (y >> 2); un = (2 * r + (j >> 5)) * 128 + 4 * (j & 31) + (y & 3); }
            const int b = un >> 7, cb = un & 127, hw = 1 << (cb >> 5);
            const bf16* src = HN + (size_t)b * SEQ * DM + cb * 16;
            bf16* dst = DD + (size_t)b * SEQ * DM + cb * 16;
            v4u h[16];
#pragma unroll
            for (int j = 0; j < 16; ++j) { const int idx = F.tid + NTHR * j, token = idx >> 1, half = idx & 1; h[j] = *(const GAS v4u*)(src + (size_t)token * DM + half * 8); }
            __syncthreads();
#pragma unroll
            for (int j = 0; j < 16; ++j) { const int idx = F.tid + NTHR * j, token = idx >> 1, half = idx & 1; *(LAS v4u*)(F.lds + (token >> 6) * PR + (token & 63) * 32 + half * 16) = h[j]; }
            __syncthreads();
#pragma unroll 1
            for (int pass = 0; pass < 2; ++pass) {
                const int line = F.tid >> 3, cp = F.tid & 7;
                const int base = (pass == 0 ? line * PR : line * 32) + cp * 4, stride = pass == 0 ? 32 : PR;
                int hwv = hw; asm volatile("" : "+s"(hwv));
                float s0 = 0.f, s1 = 0.f;
                for (int q = 0; q < hw; ++q) { const unsigned w = *(const LAS unsigned*)(F.lds + base + q * stride); s0 += bflo(w); s1 += bfhi(w); }
                unsigned o[64];
#pragma unroll
                for (int p = 0; p < 64; ++p) {
                    const int lo_ = p - hwv < 0 ? 0 : p - hwv, hi_ = p + hwv - 1 > 63 ? 63 : p + hwv - 1; const float inv = __builtin_amdgcn_rcpf((float)(hi_ - lo_ + 1));
                    o[p] = pk2(s0 * inv, s1 * inv);
                    const int pi = p + hw > 63 ? 63 : p + hw, po = p - hw < 0 ? 0 : p - hw; const float fi = p + hw <= 63 ? 1.0f : 0.0f, fo = p - hw >= 0 ? 1.0f : 0.0f;
                    const unsigned wi = *(const LAS unsigned*)(F.lds + base + pi * stride), wo = *(const LAS unsigned*)(F.lds + base + po * stride);
                    s0 += fi * bflo(wi) - fo * bflo(wo); s1 += fi * bfhi(wi) - fo * bfhi(wo);
                    if ((p & 7) == 7) __builtin_amdgcn_sched_barrier(0);
                }
#pragma unroll
                for (int p = 0; p < 64; ++p) *(LAS unsigned*)(F.lds + base + p * stride) = o[p];
                __syncthreads();
            }
#pragma unroll
            for (int j = 0; j < 16; ++j) { const int idx = F.tid + NTHR * j, token = idx >> 1, half = idx & 1;
                const v4u m = *(const LAS v4u*)(F.lds + (token >> 6) * PR + (token & 63) * 32 + half * 16);
                v4u ov; ov.x = pk2(bflo(m.x) - bflo(h[j].x), bfhi(m.x) - bfhi(h[j].x)); ov.y = pk2(bflo(m.y) - bflo(h[j].y), bfhi(m.y) - bfhi(h[j].y));
                ov.z = pk2(bflo(m.z) - bflo(h[j].z), bfhi(m.z) - bfhi(h[j].z)); ov.w = pk2(bflo(m.w) - bflo(h[j].w), bfhi(m.w) - bfhi(h[j].w));
                *(GAS v4u*)(dst + (size_t)token * DM + half * 8) = ov; }
        }
        __syncthreads();
    }
    SEAM(16);
    if (IN(18)) {
        struct PoolOrder {
            int G, c; const char* D; const char* W;
            __device__ __forceinline__ bool next(int i, pg8::Unit& u) const {
                const int L = i * G + c; if (L >= 512) return false;
                pg8::tile_of(L, 64, 8, u.pm, u.pn); const int g = u.pn >> 1; u.ty = 0;
                u.A = D + ((size_t)u.pm * 256 * DM + g * 512) * 2; u.B = W + ((size_t)g * 512 * 512 + (size_t)(u.pn & 1) * 256 * 512) * 2; return true;
            }
        } S{F.G, (int)blockIdx.x, (const char*)DD, (const char*)Wpool};
        pg8::Gemm g{512, DM, 512};
        pg8::EpiResid<false> E{XB, XB, (pg8::bf16_t*)XB, mod + ((size_t)(1 * 5) * 9 + 5) * DM, 9 * DM, args.in[I_POOLS], 1.0f};
        pg8::gemm_phase<pg8::EpiResid<false>, PoolOrder, true, true>(F.lds, g, S, E);
    }
    SEAM(18);
    if (IN(19)) norm_pass_h(F, XB, ML, mod, 1, 6, HN, F8_UP);
    SEAM(19);
    if (IN(20)) FFN_UP(3, ML);
    SEAM(20);
    if (IN(21)) FFN_DN(3, ML, false, XB, XB, 1, 8);
    SEAM(21);
    if (IN(22)) {
        { int row = F.gw; v4u vn[4];
          if (row < ML) {
#pragma unroll
              for (int q = 0; q < 4; ++q) vn[q] = *(const GAS v4u*)(XB + (size_t)row * DM + 8 * F.lane + 512 * q); }
          while (row < ML) {
            v4u v[4]; float s2 = 0.f;
#pragma unroll
            for (int q = 0; q < 4; ++q) v[q] = vn[q];
            const int rn = row + F.NGW;
            if (rn < ML) {
#pragma unroll
                for (int q = 0; q < 4; ++q) vn[q] = *(const GAS v4u*)(XB + (size_t)rn * DM + 8 * F.lane + 512 * q); }
            f32x4 x0[4], x1[4];
#pragma unroll
            for (int q = 0; q < 4; ++q) { x0[q] = (f32x4){bflo(v[q].x), bfhi(v[q].x), bflo(v[q].y), bfhi(v[q].y)}; x1[q] = (f32x4){bflo(v[q].z), bfhi(v[q].z), bflo(v[q].w), bfhi(v[q].w)};
                s2 += ((x0[q].x * x0[q].x + x0[q].y * x0[q].y) + (x0[q].z * x0[q].z + x0[q].w * x0[q].w)) + ((x1[q].x * x1[q].x + x1[q].y * x1[q].y) + (x1[q].z * x1[q].z + x1[q].w * x1[q].w)); }
            const float rstd = 1.0f / sqrtf(wave_sum(s2) * (1.0f / DM) + 1e-6f);
#pragma unroll
            for (int q = 0; q < 4; ++q) { const int col = 8 * F.lane + 512 * q;
                *(GAS f32x4*)(args.out + (size_t)row * DM + col) = x0[q] * rstd * *(const f32x4*)(args.in[I_FGAIN] + col);
                *(GAS f32x4*)(args.out + (size_t)row * DM + col + 4) = x1[q] * rstd * *(const f32x4*)(args.in[I_FGAIN] + col + 4); }
            row = rn;
          } }
    }
#undef IN
#undef SEAM
}

extern "C" void kernel_launch(void* const* d_in, const int* in_sizes, int n_in, void* d_out, int out_size, void* d_ws, size_t ws_size, hipStream_t stream) {
    static int grid = 0;
    if (grid == 0) {
        if (n_in != 29 || in_sizes[0] != ML * DM || out_size != ML * DM || ws_size < WS_END) { fprintf(stderr, "kernel_launch: unexpected shapes (n_in %d, ws %zu)\n", n_in, ws_size); grid = -1; return; }
        int dev = 0, cus = 0, per_cu = 0;
        if (hipGetDevice(&dev) != hipSuccess || hipDeviceGetAttribute(&cus, hipDeviceAttributeMultiprocessorCount, dev) != hipSuccess) { grid = -1; return; }
        if (hipFuncSetAttribute((const void*)mk_fwd, hipFuncAttributeMaxDynamicSharedMemorySize, LDS_BYTES) != hipSuccess) { grid = -1; return; }
        if (hipOccupancyMaxActiveBlocksPerMultiprocessor(&per_cu, (const void*)mk_fwd, NTHR, LDS_BYTES) != hipSuccess || per_cu < 1) { fprintf(stderr, "kernel_launch: occupancy query says %d\n", per_cu); }
        (void)hipGetLastError();
        grid = cus;
    }
    if (grid < 0) return;
    if (hipMemsetAsync((char*)d_ws + WS_CTL, 0, CTL_ZERO_BYTES, stream) != hipSuccess) return;
    Args a{};
    for (int i = 0; i < 29; ++i) a.in[i] = (const float*)d_in[i];
    a.out = (float*)d_out; a.ws = (unsigned char*)d_ws;
#if MK_PER_PHASE_LAUNCH
    for (int ph = 0; ph < NPHASE; ++ph) { a.ph_lo = ph; a.ph_hi = ph + 1; hipLaunchKernelGGL(mk_fwd, dim3(grid), dim3(NTHR), LDS_BYTES, stream, a); }
#else
    a.ph_lo = 0; a.ph_hi = NPHASE;
    hipLaunchKernelGGL(mk_fwd, dim3(grid), dim3(NTHR), LDS_BYTES, stream, a);
#endif
}
```
